# Optimizing an MI355X kernel written in HIP

```python
import jax, jax.numpy as jnp
from jax import lax
import numpy as np

D_MODEL = 1024
BATCH = 8
SEQ = 2048
DEPTH = 1
DEC_BATCH = 128
DEC_SEQ = 1
PAST_LEN = 16384
PAGE_SIZE = 128

RWKV_WIDTH = D_MODEL // 2
RWKV_HEAD = 64
RWKV_HEADS = RWKV_WIDTH // RWKV_HEAD
RWKV_DECAY_LORA = 64
RWKV_A_LORA = 64
RWKV_GATE_LORA = 128
RWKV_PROJ = 3 * RWKV_WIDTH + RWKV_DECAY_LORA + RWKV_A_LORA + RWKV_GATE_LORA
RWKV_SPLITS = (RWKV_WIDTH, 2 * RWKV_WIDTH, 3 * RWKV_WIDTH,
               3 * RWKV_WIDTH + RWKV_DECAY_LORA, 3 * RWKV_WIDTH + RWKV_DECAY_LORA + RWKV_A_LORA)
RWKV_GN_EPS = 64e-5
L2_EPS = 1e-12
HGRN_WIDTH = D_MODEL // 2
HGRN_HEADS = 4
HGRN_HEAD = HGRN_WIDTH // HGRN_HEADS
HGRN_PROJ = 4 * HGRN_WIDTH
HGRN_CHUNK = 64
GATE_PROJ = 2 * D_MODEL
IN_PROJ = RWKV_PROJ + HGRN_PROJ + GATE_PROJ
D_FF = ((8 * D_MODEL + 3 * 256 - 1) // (3 * 256)) * 256
RMS_EPS = 1e-6

kernel_name = 'rwkv7_hgrn2_gated_parallel_decoder_step'


def _rms_norm(x, g):
    xf = x.astype(jnp.float32)
    y = xf * lax.rsqrt(jnp.mean(xf * xf, axis=-1, keepdims=True) + RMS_EPS)
    return (y * g.astype(jnp.float32)).astype(x.dtype)


def _rwkv7_mixer(p, shift_prev, wkv0, mu, w0, w2, a0, a2, g2, k_k, k_a, r_k, ln_g, ln_b):
    B, T, _ = p.shape
    f32 = jnp.float32
    pf = p.astype(f32)
    p_prev = jnp.concatenate([shift_prev[:, None, :].astype(f32), pf[:, :-1]], axis=1)
    ps = pf + mu.astype(f32) * (p_prev - pf)
    r, k, v, wd, ad, gd = jnp.split(ps, list(RWKV_SPLITS), axis=-1)
    w = -jax.nn.softplus(-(w0 + jnp.tanh(wd) @ w2)) - 0.5
    decay = jnp.exp(-jnp.exp(w))
    a = jax.nn.sigmoid(a0 + ad @ a2)
    g = jax.nn.sigmoid(gd) @ g2

    def heads(t):
        return t.reshape(B, T, RWKV_HEADS, RWKV_HEAD)

    kk = heads(k * k_k)
    kk = kk / jnp.maximum(jnp.linalg.norm(kk, axis=-1, keepdims=True), L2_EPS)
    k = k * (1.0 + (a - 1.0) * k_a)
    r_h, k_h, v_h, w_h, a_h = heads(r), heads(k), heads(v), heads(decay), heads(a)
    b_h = kk * a_h

    def step(S, inp):
        r_t, w_t, k_t, v_t, aa_t, bb_t = inp
        sa = jnp.einsum('bhvk,bhk->bhv', S, aa_t)
        S = (S * w_t[:, :, None, :] + sa[..., None] * bb_t[:, :, None, :]
             + v_t[..., None] * k_t[:, :, None, :])
        y = jnp.einsum('bhvk,bhk->bhv', S, r_t)
        return S, y

    seq = tuple(jnp.moveaxis(t, 1, 0) for t in (r_h, w_h, k_h, v_h, -kk, b_h))
    S_T, y = lax.scan(step, wkv0.astype(f32), seq)
    y = jnp.moveaxis(y, 0, 1)
    mean = jnp.mean(y, axis=-1, keepdims=True)
    var = jnp.mean(jnp.square(y - mean), axis=-1, keepdims=True)
    y = ((y - mean) * lax.rsqrt(var + RWKV_GN_EPS)).reshape(B, T, RWKV_WIDTH) * ln_g + ln_b
    bonus = jnp.sum(r_h * k_h * r_k, axis=-1, keepdims=True) * v_h
    out = (y + bonus.reshape(B, T, RWKV_WIDTH)) * g
    return out.astype(p.dtype), S_T.astype(wkv0.dtype), p[:, -1]


def _gla_chunkwise(q, k, v, log_f, S0):
    B, T, H, K = q.shape
    V = v.shape[-1]
    C = min(HGRN_CHUNK, T)
    nc = -(-T // C)
    pad = nc * C - T

    def blocks(t):
        t = jnp.pad(t, ((0, 0), (0, pad), (0, 0), (0, 0)))
        return t.reshape(B, nc, C, H, t.shape[-1]).transpose(1, 0, 3, 2, 4)

    causal = jnp.tril(jnp.ones((C, C), dtype=bool))

    def step(S, inp):
        qc, kc, vc, gc = inp
        b = jnp.cumsum(gc, axis=2)
        inter = jnp.einsum('bhtk,bhkv->bhtv', qc * jnp.exp(b), S)
        diff = jnp.where(causal[:, :, None], b[:, :, :, None, :] - b[:, :, None, :, :], -jnp.inf)
        scores = jnp.einsum('bhtk,bhtsk,bhsk->bhts', qc, jnp.exp(diff), kc)
        intra = jnp.einsum('bhts,bhsv->bhtv', scores, vc)
        b_last = b[:, :, -1:, :]
        S = (jnp.exp(b_last[:, :, 0, :])[..., None] * S
             + jnp.einsum('bhsk,bhsv->bhkv', kc * jnp.exp(b_last - b), vc))
        return S, inter + intra

    S_T, o = lax.scan(step, S0, tuple(blocks(t) for t in (q, k, v, log_f)))
    o = o.transpose(1, 0, 3, 2, 4).reshape(B, nc * C, H, V)[:, :T]
    return o, S_T


def _hgrn2_mixer(p, S0, lb, norm_g):
    B, T, _ = p.shape
    f32 = jnp.float32
    q, f_logit, i, og = jnp.split(p.astype(f32), 4, axis=-1)
    f = lb + (1.0 - lb) * jax.nn.sigmoid(f_logit)
    log_f = jnp.log(f)
    k = 1.0 - f

    def heads(t):
        return t.reshape(B, T, HGRN_HEADS, HGRN_HEAD)

    o, S_T = _gla_chunkwise(heads(jax.nn.silu(q)), heads(k), heads(i), heads(log_f), S0.astype(f32))
    o = o * lax.rsqrt(jnp.mean(o * o, axis=-1, keepdims=True) + RMS_EPS)
    o = o.reshape(B, T, HGRN_WIDTH) * norm_g * jax.nn.sigmoid(og)
    return o.astype(p.dtype), S_T.astype(S0.dtype)


def _trunk(x, wkv0, shift0, hgrn0, prm):
    lb_all = jnp.cumsum(jax.nn.softmax(prm['hgrn_lb'].astype(jnp.float32), axis=0), axis=0)
    new_wkv, new_shift, new_hgrn = [], [], []
    for l in range(DEPTH):
        h = _rms_norm(x, prm['norm_mix_g'][l])
        proj = h @ prm['w_in'][l]
        p_rwkv, p_hgrn, p_gate = jnp.split(proj, [RWKV_PROJ, RWKV_PROJ + HGRN_PROJ], axis=-1)
        o_a, wkv_l, shift_l = _rwkv7_mixer(
            p_rwkv, shift0[l], wkv0[l], prm['rwkv_mu'][l], prm['rwkv_w0'][l], prm['rwkv_w2'][l],
            prm['rwkv_a0'][l], prm['rwkv_a2'][l], prm['rwkv_g2'][l], prm['rwkv_k_k'][l],
            prm['rwkv_k_a'][l], prm['rwkv_r_k'][l], prm['rwkv_ln_g'][l], prm['rwkv_ln_b'][l])
        o_b, hgrn_l = _hgrn2_mixer(p_hgrn, hgrn0[l], lb_all[l], prm['hgrn_norm_g'][l])
        gate_a, gate_b = jnp.split(jax.nn.sigmoid(p_gate), 2, axis=-1)
        merged = gate_a * (o_a @ prm['w_up_a'][l]) + gate_b * (o_b @ prm['w_up_b'][l])
        x = x + merged @ prm['w_out'][l]
        h = _rms_norm(x, prm['norm_ffn_g'][l])
        x = x + (jax.nn.silu(h @ prm['w_ffn_gate'][l]) * (h @ prm['w_ffn_up'][l])) @ prm['w_ffn_down'][l]
        new_wkv.append(wkv_l)
        new_shift.append(shift_l)
        new_hgrn.append(hgrn_l)
    y = _rms_norm(x, prm['norm_final_g'])
    return y, jnp.stack(new_wkv), jnp.stack(new_shift), jnp.stack(new_hgrn)


def setup_inputs(seed: int = 0) -> dict:
    key = jax.random.key(seed)
    ks = jax.random.split(key, 32)
    f32 = jnp.float32

    def nrm(k, shape, scale):
        return jax.random.normal(k, shape, f32) * scale

    L = DEPTH
    return {
        'x_prompt': nrm(ks[0], (BATCH, SEQ, D_MODEL), 1.0),
        'x_sample': nrm(ks[1], (DEC_BATCH, DEC_SEQ, D_MODEL), 1.0),
        'state_rwkv_wkv': nrm(ks[2], (L, DEC_BATCH, RWKV_HEADS, RWKV_HEAD, RWKV_HEAD), 0.5),
        'state_rwkv_shift': nrm(ks[3], (L, DEC_BATCH, RWKV_PROJ), 1.0),
        'state_hgrn': nrm(ks[4], (L, DEC_BATCH, HGRN_HEADS, HGRN_HEAD, HGRN_HEAD), 0.5),
        'norm_mix_g': 1.0 + nrm(ks[5], (L, D_MODEL), 0.02),
        'w_in': nrm(ks[6], (L, D_MODEL, IN_PROJ), D_MODEL ** -0.5),
        'rwkv_mu': jax.random.uniform(ks[7], (L, RWKV_PROJ), f32),
        'rwkv_w0': -1.0 + nrm(ks[8], (L, RWKV_WIDTH), 0.3),
        'rwkv_w2': nrm(ks[9], (L, RWKV_DECAY_LORA, RWKV_WIDTH), 0.1),
        'rwkv_a0': nrm(ks[10], (L, RWKV_WIDTH), 0.1),
        'rwkv_a2': nrm(ks[11], (L, RWKV_A_LORA, RWKV_WIDTH), RWKV_A_LORA ** -0.5),
        'rwkv_g2': nrm(ks[12], (L, RWKV_GATE_LORA, RWKV_WIDTH), RWKV_GATE_LORA ** -0.5),
        'rwkv_k_k': 0.85 + nrm(ks[13], (L, RWKV_WIDTH), 0.02),
        'rwkv_k_a': 1.0 + nrm(ks[14], (L, RWKV_WIDTH), 0.02),
        'rwkv_r_k': nrm(ks[15], (L, RWKV_HEADS, RWKV_HEAD), 0.1),
        'rwkv_ln_g': 1.0 + nrm(ks[16], (L, RWKV_WIDTH), 0.02),
        'rwkv_ln_b': nrm(ks[17], (L, RWKV_WIDTH), 0.02),
        'w_up_a': nrm(ks[18], (L, RWKV_WIDTH, D_MODEL), RWKV_WIDTH ** -0.5),
        'hgrn_lb': nrm(ks[19], (L + 1, HGRN_WIDTH), 0.1),
        'hgrn_norm_g': 1.0 + nrm(ks[20], (L, HGRN_WIDTH), 0.02),
        'w_up_b': nrm(ks[21], (L, HGRN_WIDTH, D_MODEL), HGRN_WIDTH ** -0.5),
        'w_out': nrm(ks[22], (L, D_MODEL, D_MODEL), D_MODEL ** -0.5),
        'norm_ffn_g': 1.0 + nrm(ks[23], (L, D_MODEL), 0.02),
        'w_ffn_gate': nrm(ks[24], (L, D_MODEL, D_FF), D_MODEL ** -0.5),
        'w_ffn_up': nrm(ks[25], (L, D_MODEL, D_FF), D_MODEL ** -0.5),
        'w_ffn_down': nrm(ks[26], (L, D_FF, D_MODEL), D_FF ** -0.5),
        'norm_final_g': 1.0 + nrm(ks[27], (D_MODEL,), 0.02),
    }


def reference(x_prompt, x_sample, state_rwkv_wkv, state_rwkv_shift, state_hgrn,
              norm_mix_g, w_in, rwkv_mu, rwkv_w0, rwkv_w2, rwkv_a0, rwkv_a2, rwkv_g2,
              rwkv_k_k, rwkv_k_a, rwkv_r_k, rwkv_ln_g, rwkv_ln_b, w_up_a, hgrn_lb,
              hgrn_norm_g, w_up_b, w_out, norm_ffn_g, w_ffn_gate, w_ffn_up, w_ffn_down,
              norm_final_g):
    prm = dict(norm_mix_g=norm_mix_g, w_in=w_in, rwkv_mu=rwkv_mu, rwkv_w0=rwkv_w0,
               rwkv_w2=rwkv_w2, rwkv_a0=rwkv_a0, rwkv_a2=rwkv_a2, rwkv_g2=rwkv_g2,
               rwkv_k_k=rwkv_k_k, rwkv_k_a=rwkv_k_a, rwkv_r_k=rwkv_r_k, rwkv_ln_g=rwkv_ln_g,
               rwkv_ln_b=rwkv_ln_b, w_up_a=w_up_a, hgrn_lb=hgrn_lb, hgrn_norm_g=hgrn_norm_g,
               w_up_b=w_up_b, w_out=w_out, norm_ffn_g=norm_ffn_g, w_ffn_gate=w_ffn_gate,
               w_ffn_up=w_ffn_up, w_ffn_down=w_ffn_down, norm_final_g=norm_final_g)
    bp = x_prompt.shape[0]
    dt = x_prompt.dtype
    wkv_zero = jnp.zeros((DEPTH, bp, RWKV_HEADS, RWKV_HEAD, RWKV_HEAD), dt)
    shift_zero = jnp.zeros((DEPTH, bp, RWKV_PROJ), dt)
    hgrn_zero = jnp.zeros((DEPTH, bp, HGRN_HEADS, HGRN_HEAD, HGRN_HEAD), dt)
    y_prompt, wkv_p, shift_p, hgrn_p = _trunk(x_prompt, wkv_zero, shift_zero, hgrn_zero, prm)
    y_sample, wkv_s, shift_s, hgrn_s = _trunk(x_sample, state_rwkv_wkv, state_rwkv_shift, state_hgrn, prm)
    return (y_prompt, y_sample, wkv_p, shift_p, hgrn_p, wkv_s, shift_s, hgrn_s)
```

```cpp
#include <hip/hip_runtime.h>
#include <hip/hip_cooperative_groups.h>
#include <cstdio>
namespace cg = cooperative_groups;
namespace pg8 {
#define PG8_LAS __attribute__((address_space(3)))
typedef unsigned short bf16_t;
typedef short bf16x8 __attribute__((ext_vector_type(8)));
typedef float f32x4 __attribute__((ext_vector_type(4)));
typedef unsigned u32x4 __attribute__((ext_vector_type(4)));
constexpr int BM = 256, BK = 64, HALF = 128, HTB = HALF * BK * 2  , STAGE_BYTES = 8 * HTB, NXCD = 8, WGM = 8;

__host__ __device__ __forceinline__ int lds_byte(int r, int c) { const int st = (r >> 4) * 2 + (c >> 5), rr = r & 15, cc = c & 31, ob = rr * 64 + cc * 2; return st * 1024 + (ob ^ (((ob >> 9) & 1) << 5)); }
__host__ __device__ __forceinline__ void stage_rc(int b, int& R, int& C) { const int st = b / 1024, sb = b % 1024, swz = sb ^ (((sb >> 9) & 1) << 5); R = (st >> 1) * 16 + swz / 64; C = (st & 1) * 32 + (swz % 64) / 2; }
__host__ __device__ __forceinline__ int perm32(int rho) { const int n = rho >> 4, i = rho & 15; return 8 * (i >> 2) + 4 * n + (i & 3); }

struct Unit { int pm, pn; };
struct Gemm { const bf16_t* A; const bf16_t* Bt; int M, N, K; };

struct StaticOrder {
    int nM, nN, nwg, G, c;
    __host__ __device__ void init(int M, int N, int G_, int c_) { nM = M / BM; nN = N / BM; nwg = nM * nN; G = G_; c = c_; }
    __host__ __device__ bool next(int i, Unit& u) const {
        const long L = (long)i * G + c; if (L >= nwg) return false;
        int wgid = (int)L; { const int q = nwg / NXCD, r = nwg % NXCD, xcd = wgid % NXCD, off = wgid / NXCD; wgid = (xcd < r ? xcd * (q + 1) : r * (q + 1) + (xcd - r) * q) + off; }
        const int nig = WGM * nN, gid = wgid / nig, fm = gid * WGM, gsz = (nM - fm) < WGM ? (nM - fm) : WGM;
        u.pm = fm + ((wgid % nig) % gsz); u.pn = (wgid % nig) / gsz; return true;
    }
    __device__ __forceinline__ void a_ready(const Unit&) const {}
    __device__ __forceinline__ void done(const Unit&) const {}
};
typedef float f32x2 __attribute__((ext_vector_type(2)));
typedef __bf16 bf16x2n __attribute__((ext_vector_type(2)));
__device__ __forceinline__ unsigned cvt_pk_bf16(float lo, float hi) { const f32x2 v = {lo, hi}; return __builtin_bit_cast(unsigned, __builtin_convertvector(v, bf16x2n)); }
template <class Epi, class Sched>
__device__ __forceinline__ void gemm_phase(PG8_LAS unsigned char* lds, const Gemm g, const Sched& S, const Epi& E) {
    const int tid = threadIdx.x, wid = __builtin_amdgcn_readfirstlane(tid >> 6), lane = tid & 63, wr = wid >> 2, wc = wid & 3, fr = lane & 15, fq = lane >> 4;
    const int K = g.K, nt = K / BK;
    unsigned voffA[2], voffB[2];
#pragma unroll
    for (int i = 0; i < 2; ++i) { int R, C; stage_rc(tid * 16 + i * 8192, R, C); const int Rb = Epi::PERM ? ((R & ~31) + perm32(R & 31)) : R;
        voffA[i] = (unsigned)(R * K + C) * 2u; voffB[i] = (unsigned)(Rb * K + C) * 2u; }
    const size_t kstep = (size_t)(BK * 2);
    const size_t hstep = (size_t)HALF * K * 2;
    const size_t tstep = 2 * hstep;
    const unsigned ldsw = (unsigned)wid * 1024u;
    const int aoff = lds_byte(wr * 64 + fr, fq * 8), boff = lds_byte(wc * 32 + fr, fq * 8);
#define PG8_SA(b, h) (((b) * 2 + (h)) * HTB)
#define PG8_SB(b, h) ((4 + (b) * 2 + (h)) * HTB)
#define PG8_STAGE(bufoff, gbase, voff) do { _Pragma("unroll") for (int _i = 0; _i < 2; ++_i) \
        __builtin_amdgcn_global_load_lds((const unsigned*)((const char*)(gbase) + (voff)[_i]), (PG8_LAS unsigned*)(lds + (bufoff) + ldsw + _i * 8192), 16, 0, 0); } while (0)
#define PG8_LDA(dst, b, h) do { _Pragma("unroll") for (int m = 0; m < 4; ++m) _Pragma("unroll") for (int k = 0; k < 2; ++k) dst[m][k] = *(const PG8_LAS bf16x8*)(lds + PG8_SA(b, h) + aoff + m * 2048 + k * 1024); } while (0)
#define PG8_LDB(dst, b, h) do { _Pragma("unroll") for (int n = 0; n < 2; ++n) _Pragma("unroll") for (int k = 0; k < 2; ++k) dst[n][k] = *(const PG8_LAS bf16x8*)(lds + PG8_SB(b, h) + boff + n * 2048 + k * 1024); } while (0)
#define PG8_MMA(ai, bj, At, Bt) do { __builtin_amdgcn_s_setprio(1); _Pragma("unroll") for (int m = 0; m < 4; ++m) _Pragma("unroll") for (int n = 0; n < 2; ++n) _Pragma("unroll") for (int k = 0; k < 2; ++k) \
        acc[ai][bj][m][n] = __builtin_amdgcn_mfma_f32_16x16x32_bf16(Bt[n][k], At[m][k], acc[ai][bj][m][n], 0, 0, 0); __builtin_amdgcn_s_setprio(0); } while (0)
#define PG8_WAIT_V(n) asm volatile("s_waitcnt vmcnt(" #n ")" ::: "memory")
#define PG8_WAIT_L(n) asm volatile("s_waitcnt lgkmcnt(" #n ")" ::: "memory")
#define PG8_BAR __builtin_amdgcn_s_barrier()
#define PG8_SCHED __builtin_amdgcn_sched_barrier(0)
    Unit cur, nxt; int ui = 0;
    if (!S.next(0, cur)) return;
    f32x4 acc[2][2][4][2];
#pragma unroll
    for (int a = 0; a < 2; ++a)
#pragma unroll
        for (int b = 0; b < 2; ++b)
#pragma unroll
            for (int m = 0; m < 4; ++m)
#pragma unroll
                for (int n = 0; n < 2; ++n) acc[a][b][m][n] = (f32x4){0.f, 0.f, 0.f, 0.f};
    bf16x8 At[4][2], B0[2][2], B1[2][2];
    const char* cA = (const char*)g.A + (size_t)cur.pm * tstep; const char* cB = (const char*)g.Bt + (size_t)cur.pn * tstep;
    S.a_ready(cur);
    PG8_STAGE(PG8_SB(0, 0), cB, voffB); PG8_STAGE(PG8_SA(0, 0), cA, voffA); PG8_STAGE(PG8_SB(0, 1), cB + hstep, voffB); PG8_STAGE(PG8_SA(0, 1), cA + hstep, voffA);
    if (wr == 1) PG8_BAR;
    PG8_WAIT_V(4); PG8_BAR;
    PG8_STAGE(PG8_SB(1, 0), cB + kstep, voffB); PG8_STAGE(PG8_SA(1, 0), cA + kstep, voffA); PG8_STAGE(PG8_SB(1, 1), cB + hstep + kstep, voffB);
    PG8_WAIT_V(6); PG8_BAR;
    for (;;) {
        const bool has_next = S.next(ui + 1, nxt);
        const char* nA = has_next ? (const char*)g.A + (size_t)nxt.pm * tstep : cA; const char* nB = has_next ? (const char*)g.Bt + (size_t)nxt.pn * tstep : cB;
        for (int t = 0; t < nt; t += 2) {
            const bool last = (t == nt - 2);
            const char* a1 = cA + (size_t)(t + 1) * kstep;
            const char* a2 = last ? nA : cA + (size_t)(t + 2) * kstep; const char* b2 = last ? nB : cB + (size_t)(t + 2) * kstep;
            const char* a3 = a2 + kstep; const char* b3 = b2 + kstep;
            if (last && has_next) S.a_ready(nxt);
            PG8_LDB(B0, 0, 0); PG8_SCHED; PG8_LDA(At, 0, 0); PG8_STAGE(PG8_SA(1, 1), a1 + hstep, voffA);
            PG8_WAIT_L(8); PG8_BAR; PG8_WAIT_L(0); PG8_MMA(0, 0, At, B0); PG8_BAR; PG8_SCHED;
            PG8_LDB(B1, 0, 1); PG8_STAGE(PG8_SB(0, 0), b2, voffB);
            PG8_BAR; PG8_WAIT_L(0); PG8_MMA(0, 1, At, B1); PG8_BAR;
            PG8_LDA(At, 0, 1); PG8_STAGE(PG8_SA(0, 0), a2, voffA);
            PG8_BAR; PG8_WAIT_L(0); PG8_MMA(1, 0, At, B0); PG8_BAR; PG8_SCHED;
            PG8_STAGE(PG8_SB(0, 1), b2 + hstep, voffB);
            PG8_WAIT_V(6); PG8_BAR; PG8_MMA(1, 1, At, B1); PG8_BAR;
            PG8_LDB(B0, 1, 0); PG8_SCHED; PG8_LDA(At, 1, 0); PG8_STAGE(PG8_SA(0, 1), a2 + hstep, voffA);
            PG8_WAIT_L(8); PG8_BAR; PG8_WAIT_L(0); PG8_MMA(0, 0, At, B0); PG8_BAR; PG8_SCHED;
            PG8_LDB(B1, 1, 1); PG8_STAGE(PG8_SB(1, 0), b3, voffB);
            PG8_BAR; PG8_WAIT_L(0); PG8_MMA(0, 1, At, B1); PG8_BAR;
            PG8_LDA(At, 1, 1); PG8_STAGE(PG8_SA(1, 0), a3, voffA);
            PG8_BAR; PG8_WAIT_L(0); PG8_MMA(1, 0, At, B0); PG8_BAR; PG8_SCHED;
            PG8_STAGE(PG8_SB(1, 1), b3 + hstep, voffB);
            PG8_WAIT_V(6); PG8_BAR; PG8_MMA(1, 1, At, B1); PG8_BAR;
        }
        if constexpr (!Epi::AFTER_DRAIN) { E(acc, cur, wr, wc, fr, fq); S.done(cur); }
        if (!has_next) break;
#pragma unroll
        for (int a = 0; a < 2; ++a)
#pragma unroll
            for (int b = 0; b < 2; ++b)
#pragma unroll
                for (int m = 0; m < 4; ++m)
#pragma unroll
                    for (int n = 0; n < 2; ++n) acc[a][b][m][n] = (f32x4){0.f, 0.f, 0.f, 0.f};
        cur = nxt; cA = nA; cB = nB; ++ui;
    }
    PG8_WAIT_V(0);
    if (wr == 0) PG8_BAR;
    PG8_BAR;
    if constexpr (Epi::AFTER_DRAIN) { E.fused(acc, cur, wr, wc, fr, fq, lds, wid, lane); S.done(cur); }
#undef PG8_SA
#undef PG8_SB
#undef PG8_STAGE
#undef PG8_LDA
#undef PG8_LDB
#undef PG8_MMA
#undef PG8_WAIT_V
#undef PG8_WAIT_L
#undef PG8_BAR
#undef PG8_SCHED
}
}


using pg8::bf16_t; using pg8::bf16x8; using pg8::f32x4; using pg8::u32x4; using pg8::Unit; using pg8::cvt_pk_bf16;
typedef unsigned u32x2 __attribute__((ext_vector_type(2)));

constexpr int D = 1024, TP = 16384, TSMP = 128, M = TP + TSMP, MPAD = 16640, SEQ = 2048;
constexpr int RP = 1792, NIN = 5888, DFF = 2816;
constexpr int NTHR = 512;
constexpr int LDS_BYTES = 140 * 1024;

constexpr size_t O_Y = 0, O_WKVP = (size_t)M * D, O_SHP = O_WKVP + 8 * 8 * 64 * 64, O_HGP = O_SHP + 8 * RP,
                 O_WKVS = O_HGP + 8 * 4 * 128 * 128, O_SHS = O_WKVS + (size_t)128 * 8 * 64 * 64, O_HGS = O_SHS + 128 * RP;
constexpr size_t WS_BTIN = 0, WS_BTUPA = WS_BTIN + (size_t)NIN * D * 2, WS_BTUPB = WS_BTUPA + (size_t)D * 512 * 2, WS_BTOUT = WS_BTUPB + (size_t)D * 512 * 2,
                 WS_BTGU = WS_BTOUT + (size_t)D * D * 2, WS_BTDN = WS_BTGU + (size_t)2 * DFF * D * 2, WS_MISC = WS_BTDN + (size_t)D * DFF * 2,
                 WS_H = WS_MISC + 262144, WS_PR = WS_H + (size_t)MPAD * D * 2, WS_QS = WS_PR + (size_t)MPAD * RP * 2, WS_F = WS_QS + (size_t)MPAD * 512 * 2,
                 WS_HI = WS_F + (size_t)MPAD * 512 * 4, WS_OG = WS_HI + (size_t)MPAD * 512 * 2, WS_OA = WS_OG + (size_t)MPAD * 512 * 2,
                 WS_OB = WS_OA + (size_t)MPAD * 512 * 2, WS_END = WS_OB + (size_t)MPAD * 512 * 2;
constexpr size_t WS_MG = WS_H, WS_ACT = WS_PR, WS_X1B = WS_OA;
static_assert((size_t)MPAD * DFF * 2 <= WS_OA - WS_PR, "ACT alias");
static_assert(WS_END <= (size_t)256 * 1024 * 1024, "workspace");

struct Params {
    const float* in[28];
    float* out;
    unsigned char* ws;
    int ph_lo, ph_hi;
};

__device__ __forceinline__ float sigmoidf_(float x) { return __builtin_amdgcn_rcpf(1.f + __expf(-x)); }
__device__ __forceinline__ float bf2f(bf16_t v) { return __uint_as_float(((unsigned)v) << 16); }
__device__ __forceinline__ bf16_t f2bf(float f) { unsigned u = __float_as_uint(f); u += 0x7FFFu + ((u >> 16) & 1u); return (bf16_t)(u >> 16); }
__device__ __forceinline__ float wave_sum(float v) {
#pragma unroll
    for (int o = 32; o >= 1; o >>= 1) v += __shfl_xor(v, o);
    return v;
}

__device__ __forceinline__ void transpose_tile(const float* __restrict__ src, int K, int N, int kt, int nt, bf16_t* __restrict__ dst, int mode, const float* __restrict__ kscale, float* tile) {
    const int tid = threadIdx.x;
    {
        const int i = tid >> 3, j0 = (tid & 7) * 8;
        const float* s = src + (size_t)(kt * 64 + i) * N + nt * 64 + j0;
        const float4 a = *(const float4*)s, b = *(const float4*)(s + 4);
        const float sc = kscale ? kscale[kt * 64 + i] : 1.f;
        float* t = tile + i * 65 + j0;
        t[0] = a.x * sc; t[1] = a.y * sc; t[2] = a.z * sc; t[3] = a.w * sc; t[4] = b.x * sc; t[5] = b.y * sc; t[6] = b.z * sc; t[7] = b.w * sc;
    }
    __syncthreads();
    {
        const int n = tid >> 3, k0 = (tid & 7) * 8;
        float v[8];
#pragma unroll
        for (int kk = 0; kk < 8; ++kk) v[kk] = tile[(k0 + kk) * 65 + n];
        u32x4 w; w.x = cvt_pk_bf16(v[0], v[1]); w.y = cvt_pk_bf16(v[2], v[3]); w.z = cvt_pk_bf16(v[4], v[5]); w.w = cvt_pk_bf16(v[6], v[7]);
        const int ncol = nt * 64 + n;
        const int drow = mode == 0 ? ncol : ((ncol >> 7) * 256 + (mode == 2 ? 128 : 0) + (ncol & 127));
        *(u32x4*)(dst + (size_t)drow * K + kt * 64 + k0) = w;
    }
    __syncthreads();
}

__device__ void phase_prep(const Params& p, unsigned char* lds) {
    float* tile = (float*)lds;
    unsigned char* ws = p.ws;
    for (int t = blockIdx.x; t < 4096; t += gridDim.x) {
        if (t < 1472) transpose_tile(p.in[6], D, NIN, t / 92, t % 92, (bf16_t*)(ws + WS_BTIN), 0, nullptr, tile);
        else if (t < 1600) { const int u = t - 1472; transpose_tile(p.in[18], 512, D, u / 16, u % 16, (bf16_t*)(ws + WS_BTUPA), 0, nullptr, tile); }
        else if (t < 1728) { const int u = t - 1600; transpose_tile(p.in[21], 512, D, u / 16, u % 16, (bf16_t*)(ws + WS_BTUPB), 0, nullptr, tile); }
        else if (t < 1984) { const int u = t - 1728; transpose_tile(p.in[22], D, D, u / 16, u % 16, (bf16_t*)(ws + WS_BTOUT), 0, nullptr, tile); }
        else if (t < 2688) { const int u = t - 1984; transpose_tile(p.in[24], D, DFF, u / 44, u % 44, (bf16_t*)(ws + WS_BTGU), 1, p.in[23], tile); }
        else if (t < 3392) { const int u = t - 2688; transpose_tile(p.in[25], D, DFF, u / 44, u % 44, (bf16_t*)(ws + WS_BTGU), 2, p.in[23], tile); }
        else { const int u = t - 3392; transpose_tile(p.in[26], DFF, D, u / 16, u % 16, (bf16_t*)(ws + WS_BTDN), 0, nullptr, tile); }
    }
    const int lane = threadIdx.x & 63, wave = threadIdx.x >> 6;
    const float* g = p.in[5];
    bf16_t* H = (bf16_t*)(ws + WS_H);
    for (int row = blockIdx.x * 8 + wave; row < M; row += gridDim.x * 8) {
        const float* x = row < TP ? p.in[0] + (size_t)row * D : p.in[1] + (size_t)(row - TP) * D;
        float4 v[4]; float ss = 0.f;
#pragma unroll
        for (int i = 0; i < 4; ++i) { v[i] = *(const float4*)(x + i * 256 + lane * 4); ss += v[i].x * v[i].x + v[i].y * v[i].y + v[i].z * v[i].z + v[i].w * v[i].w; }
        ss = wave_sum(ss);
        const float rstd = rsqrtf(ss * (1.f / D) + 1e-6f);
#pragma unroll
        for (int i = 0; i < 4; ++i) { const float4 gg = *(const float4*)(g + i * 256 + lane * 4);
            u32x2 w; w.x = cvt_pk_bf16(v[i].x * rstd * gg.x, v[i].y * rstd * gg.y); w.y = cvt_pk_bf16(v[i].z * rstd * gg.z, v[i].w * rstd * gg.w);
            *(u32x2*)(H + (size_t)row * D + i * 256 + lane * 4) = w; }
    }
    float* lb = (float*)(ws + WS_MISC); float* ssq = (float*)(ws + WS_MISC + 4096);
    const int gt = blockIdx.x * NTHR + threadIdx.x;
    if (gt < 512) lb[gt] = 1.f / (1.f + __expf(p.in[19][512 + gt] - p.in[19][gt]));
    for (int i = gt; i < MPAD; i += gridDim.x * NTHR) ssq[i] = 0.f;
}

typedef const f32x4 (&AccRef)[2][2][4][2];
__device__ __forceinline__ u32x4 pack8(const f32x4 a, const f32x4 b) { u32x4 w; w.x = cvt_pk_bf16(a[0], a[1]); w.y = cvt_pk_bf16(a[2], a[3]); w.z = cvt_pk_bf16(b[0], b[1]); w.w = cvt_pk_bf16(b[2], b[3]); return w; }
__device__ __forceinline__ void unpack8(const u32x4 w, f32x4& a, f32x4& b) {
    a[0] = __uint_as_float(w.x << 16); a[1] = __uint_as_float(w.x & 0xffff0000u); a[2] = __uint_as_float(w.y << 16); a[3] = __uint_as_float(w.y & 0xffff0000u);
    b[0] = __uint_as_float(w.z << 16); b[1] = __uint_as_float(w.z & 0xffff0000u); b[2] = __uint_as_float(w.w << 16); b[3] = __uint_as_float(w.w & 0xffff0000u); }

struct EpiIn {
    static constexpr bool PERM = true, AFTER_DRAIN = false;
    bf16_t* PR; bf16_t* QS; float* F; bf16_t* HI; bf16_t* OG; bf16_t* GATE; const float* lb; float* shp; float* shs;
    __device__ __forceinline__ void operator()(AccRef acc, const Unit& u, int wr, int wc, int fr, int fq) const {
        const int row0 = u.pm * 256 + wr * 64 + fr, cl = wc * 32 + 8 * fq;
        const int pn = u.pn;
#pragma unroll
        for (int ai = 0; ai < 2; ++ai)
#pragma unroll
            for (int m = 0; m < 4; ++m) {
                const int row = row0 + ai * 128 + m * 16;
#pragma unroll
                for (int bj = 0; bj < 2; ++bj) {
                    f32x4 v0 = acc[ai][bj][m][0], v1 = acc[ai][bj][m][1];
                    const int col = pn * 256 + bj * 128 + cl;
                    if (pn < 7) {
                        *(u32x4*)(PR + (size_t)row * RP + col) = pack8(v0, v1);
                        float* sp = nullptr;
                        if (row < TP) { if ((row & (SEQ - 1)) == SEQ - 1) sp = shp + (size_t)(row >> 11) * RP + col; }
                        else if (row < M) sp = shs + (size_t)(row - TP) * RP + col;
                        if (sp) { *(f32x4*)sp = v0; *(f32x4*)(sp + 4) = v1; }
                    } else if (pn < 15) {
                        const int hc = col - RP, ty = (pn - 7) >> 1, cc = hc - ty * 512;
                        if (ty == 0) {
#pragma unroll
                            for (int j = 0; j < 4; ++j) { v0[j] = v0[j] * sigmoidf_(v0[j]); v1[j] = v1[j] * sigmoidf_(v1[j]); }
                            *(u32x4*)(QS + (size_t)row * 512 + cc) = pack8(v0, v1);
                        } else if (ty == 1) {
                            const f32x4 l0 = *(const f32x4*)(lb + cc), l1 = *(const f32x4*)(lb + cc + 4);
#pragma unroll
                            for (int j = 0; j < 4; ++j) { v0[j] = l0[j] + (1.f - l0[j]) * sigmoidf_(v0[j]); v1[j] = l1[j] + (1.f - l1[j]) * sigmoidf_(v1[j]); }
                            *(f32x4*)(F + (size_t)row * 512 + cc) = v0; *(f32x4*)(F + (size_t)row * 512 + cc + 4) = v1;
                        } else if (ty == 2) {
                            *(u32x4*)(HI + (size_t)row * 512 + cc) = pack8(v0, v1);
                        } else {
#pragma unroll
                            for (int j = 0; j < 4; ++j) { v0[j] = sigmoidf_(v0[j]); v1[j] = sigmoidf_(v1[j]); }
                            *(u32x4*)(OG + (size_t)row * 512 + cc) = pack8(v0, v1);
                        }
                    } else {
                        const int gc = col - (RP + 2048);
#pragma unroll
                        for (int j = 0; j < 4; ++j) { v0[j] = sigmoidf_(v0[j]); v1[j] = sigmoidf_(v1[j]); }
                        if (row < M) *(u32x4*)(GATE + (size_t)row * 2048 + gc) = pack8(v0, v1);
                    }
                }
            }
    }
};

template <bool SECOND> struct EpiMerge {
    static constexpr bool PERM = true, AFTER_DRAIN = false;
    bf16_t* MG; const bf16_t* GATE;
    __device__ __forceinline__ void operator()(AccRef acc, const Unit& u, int wr, int wc, int fr, int fq) const {
        const int row0 = u.pm * 256 + wr * 64 + fr, cl = wc * 32 + 8 * fq;
#pragma unroll
        for (int ai = 0; ai < 2; ++ai)
#pragma unroll
            for (int m = 0; m < 4; ++m) {
                const int row = row0 + ai * 128 + m * 16;
#pragma unroll
                for (int bj = 0; bj < 2; ++bj) {
                    const int col = u.pn * 256 + bj * 128 + cl;
                    f32x4 g0 = {0.f, 0.f, 0.f, 0.f}, g1 = g0;
                    if (row < M) unpack8(*(const u32x4*)(GATE + (size_t)row * 2048 + (SECOND ? 1024 : 0) + col), g0, g1);
                    f32x4 v0 = acc[ai][bj][m][0] * g0, v1 = acc[ai][bj][m][1] * g1;
                    bf16_t* dst = MG + (size_t)row * D + col;
                    if (SECOND) { f32x4 p0, p1; unpack8(*(const u32x4*)dst, p0, p1); v0 += p0; v1 += p1; }
                    *(u32x4*)dst = pack8(v0, v1);
                }
            }
    }
};

struct EpiOut {
    static constexpr bool PERM = false, AFTER_DRAIN = false;
    const float* xp; const float* xs; float* X1; bf16_t* X1B; float* ssq;
    __device__ __forceinline__ void operator()(AccRef acc, const Unit& u, int wr, int wc, int fr, int fq) const {
        const int row0 = u.pm * 256 + wr * 64 + fr, col0 = u.pn * 256 + wc * 32 + 4 * fq;
#pragma unroll
        for (int ai = 0; ai < 2; ++ai)
#pragma unroll
            for (int m = 0; m < 4; ++m) {
                const int row = row0 + ai * 128 + m * 16;
                const bool ok = row < M;
                const float* xr = row < TP ? xp + (size_t)row * D : xs + (size_t)(row - TP) * D;
                float ss = 0.f;
#pragma unroll
                for (int bj = 0; bj < 2; ++bj)
#pragma unroll
                    for (int n = 0; n < 2; ++n) {
                        const int col = col0 + bj * 128 + n * 16;
                        f32x4 xv = {0.f, 0.f, 0.f, 0.f};
                        if (ok) xv = *(const f32x4*)(xr + col);
                        const f32x4 v = xv + acc[ai][bj][m][n];
                        ss += v[0] * v[0] + v[1] * v[1] + v[2] * v[2] + v[3] * v[3];
                        if (ok) *(f32x4*)(X1 + (size_t)row * D + col) = v;
                        u32x2 w; w.x = cvt_pk_bf16(v[0], v[1]); w.y = cvt_pk_bf16(v[2], v[3]);
                        *(u32x2*)(X1B + (size_t)row * D + col) = w;
                    }
                ss += __shfl_xor(ss, 16); ss += __shfl_xor(ss, 32);
                if (fq == 0) atomicAdd(ssq + row, ss);
            }
    }
};

struct EpiGU {
    static constexpr bool PERM = true, AFTER_DRAIN = false;
    bf16_t* ACT; const float* ssq;
    __device__ __forceinline__ void operator()(AccRef acc, const Unit& u, int wr, int wc, int fr, int fq) const {
        const int row0 = u.pm * 256 + wr * 64 + fr, col = u.pn * 128 + wc * 32 + 8 * fq;
#pragma unroll
        for (int ai = 0; ai < 2; ++ai)
#pragma unroll
            for (int m = 0; m < 4; ++m) {
                const int row = row0 + ai * 128 + m * 16;
                const float rstd = rsqrtf(ssq[row] * (1.f / D) + 1e-6f);
                f32x4 o[2];
#pragma unroll
                for (int n = 0; n < 2; ++n)
#pragma unroll
                    for (int j = 0; j < 4; ++j) { const float g = acc[ai][0][m][n][j] * rstd, uu = acc[ai][1][m][n][j] * rstd; o[n][j] = g * sigmoidf_(g) * uu; }
                *(u32x4*)(ACT + (size_t)row * DFF + col) = pack8(o[0], o[1]);
            }
    }
};

struct EpiDown {
    static constexpr bool PERM = false, AFTER_DRAIN = false;
    float* X;
    __device__ __forceinline__ void operator()(AccRef acc, const Unit& u, int wr, int wc, int fr, int fq) const {
        const int row0 = u.pm * 256 + wr * 64 + fr, col0 = u.pn * 256 + wc * 32 + 4 * fq;
#pragma unroll
        for (int ai = 0; ai < 2; ++ai)
#pragma unroll
            for (int m = 0; m < 4; ++m) {
                const int row = row0 + ai * 128 + m * 16;
                if (row < M) {
#pragma unroll
                    for (int bj = 0; bj < 2; ++bj)
#pragma unroll
                        for (int n = 0; n < 2; ++n) { float* q = X + (size_t)row * D + col0 + bj * 128 + n * 16; *(f32x4*)q = *(const f32x4*)q + acc[ai][bj][m][n]; }
                }
            }
    }
};

__device__ __forceinline__ f32x4 mfma16(const bf16x8 a, const bf16x8 b, const f32x4 c) { return __builtin_amdgcn_mfma_f32_16x16x32_bf16(a, b, c, 0, 0, 0); }

__device__ void rwkv_seq_item(const Params& p, unsigned char* lds, int row0, int T, int h, const float* __restrict__ S_init, const float* __restrict__ shift_prev, float* __restrict__ S_out) {
    float* sR = (float*)lds; float* sK = sR + 2048; float* sV = sK + 2048; float* sDec = sV + 2048; float* sKK = sDec + 2048; float* sBB = sKK + 2048;
    float* sA = sBB + 2048; float* sG = sA + 2048; float* sY = sG + 2048; float* sBonus = sY + 2048;
    bf16_t* sTW = (bf16_t*)(lds + 73984); bf16_t* sAD = (bf16_t*)(lds + 78592); bf16_t* sSG = (bf16_t*)(lds + 83200);
    bf16_t* w2t = (bf16_t*)(lds + 91904); bf16_t* a2t = (bf16_t*)(lds + 101120); bf16_t* g2t = (bf16_t*)(lds + 110336);
    const int tid = threadIdx.x, lane = tid & 63, wave = tid >> 6;
    const bf16_t* PR = (const bf16_t*)(p.ws + WS_PR);
    bf16_t* OA = (bf16_t*)(p.ws + WS_OA);
    const float *mu = p.in[7], *w0 = p.in[8], *w2 = p.in[9], *a0 = p.in[10], *a2 = p.in[11], *g2 = p.in[12], *k_k = p.in[13], *k_a = p.in[14], *r_k = p.in[15], *ln_g = p.in[16], *ln_b = p.in[17];
    __syncthreads();
    for (int idx = tid; idx < 64 * 64; idx += NTHR) { const int j = idx >> 6, c = idx & 63; w2t[c * 72 + j] = f2bf(w2[j * 512 + 64 * h + c]); a2t[c * 72 + j] = f2bf(a2[j * 512 + 64 * h + c]); }
    for (int idx = tid; idx < 128 * 64; idx += NTHR) { const int j = idx >> 6, c = idx & 63; g2t[c * 136 + j] = f2bf(g2[j * 512 + 64 * h + c]); }
    const int vrow = wave * 8 + (lane >> 3), kp = lane & 7;
    float S[8];
    if (S_init) { const float4 a = *(const float4*)(S_init + vrow * 64 + kp * 8), b = *(const float4*)(S_init + vrow * 64 + kp * 8 + 4);
        S[0] = a.x; S[1] = a.y; S[2] = a.z; S[3] = a.w; S[4] = b.x; S[5] = b.y; S[6] = b.z; S[7] = b.w; }
    else {
#pragma unroll
        for (int j = 0; j < 8; ++j) S[j] = 0.f; }
    for (int t0 = 0; t0 < T; t0 += 32) {
        const int nt = (T - t0) < 32 ? (T - t0) : 32;
        for (int idx = tid; idx < nt * 448; idx += NTHR) {
            const int t = idx / 448, j = idx - t * 448;
            const int col = j < 64 ? 64 * h + j : (j < 128 ? 512 + 64 * h + (j - 64) : (j < 192 ? 1024 + 64 * h + (j - 128) : 1536 + (j - 192)));
            const size_t row = (size_t)row0 + t0 + t;
            const float pc = bf2f(PR[row * RP + col]);
            float pv;
            if (t0 + t == 0) pv = shift_prev ? shift_prev[col] : 0.f; else pv = bf2f(PR[(row - 1) * RP + col]);
            const float ps = pc + mu[col] * (pv - pc);
            if (j < 64) sR[t * 64 + j] = ps; else if (j < 128) sK[t * 64 + j - 64] = ps; else if (j < 192) sV[t * 64 + j - 128] = ps;
            else if (j < 256) sTW[t * 72 + j - 192] = f2bf(tanhf(ps)); else if (j < 320) sAD[t * 72 + j - 256] = f2bf(ps); else sSG[t * 136 + j - 320] = f2bf(sigmoidf_(ps));
        }
        __syncthreads();
        {
            const int tt = wave & 1, ct = wave >> 1, i = lane & 15, q = lane >> 4;
            f32x4 aw = {0.f, 0.f, 0.f, 0.f}, aa = aw, ag = aw;
#pragma unroll
            for (int ks = 0; ks < 2; ++ks) {
                aw = mfma16(*(const bf16x8*)(w2t + (ct * 16 + i) * 72 + 8 * q + 32 * ks), *(const bf16x8*)(sTW + (tt * 16 + i) * 72 + 8 * q + 32 * ks), aw);
                aa = mfma16(*(const bf16x8*)(a2t + (ct * 16 + i) * 72 + 8 * q + 32 * ks), *(const bf16x8*)(sAD + (tt * 16 + i) * 72 + 8 * q + 32 * ks), aa);
            }
#pragma unroll
            for (int ks = 0; ks < 4; ++ks)
                ag = mfma16(*(const bf16x8*)(g2t + (ct * 16 + i) * 136 + 8 * q + 32 * ks), *(const bf16x8*)(sSG + (tt * 16 + i) * 136 + 8 * q + 32 * ks), ag);
            const int t = tt * 16 + i;
#pragma unroll
            for (int jj = 0; jj < 4; ++jj) {
                const int c = ct * 16 + 4 * q + jj, cg = 64 * h + c;
                const float z = -(w0[cg] + aw[jj]);
                const float sp = fmaxf(z, 0.f) + log1pf(__expf(-fabsf(z)));
                const float w = -sp - 0.5f;
                sDec[t * 64 + c] = __expf(-__expf(w));
                sA[t * 64 + c] = sigmoidf_(a0[cg] + aa[jj]);
                sG[t * 64 + c] = ag[jj];
            }
        }
        __syncthreads();
        for (int t = wave; t < nt; t += 8) {
            const int c = lane, cg = 64 * h + c;
            const float k = sK[t * 64 + c], a = sA[t * 64 + c];
            const float kkv = k * k_k[cg];
            const float n2 = wave_sum(kkv * kkv);
            const float kkn = kkv / fmaxf(sqrtf(n2), 1e-12f);
            const float kpv = k * (1.f + (a - 1.f) * k_a[cg]);
            sK[t * 64 + c] = kpv; sKK[t * 64 + c] = kkn; sBB[t * 64 + c] = kkn * a;
            const float bon = wave_sum(sR[t * 64 + c] * kpv * r_k[cg]);
            if (lane == 0) sBonus[t] = bon;
        }
        __syncthreads();
        for (int t = 0; t < nt; ++t) {
            const float4* pd = (const float4*)(sDec + t * 64 + kp * 8); const float4* pk = (const float4*)(sKK + t * 64 + kp * 8); const float4* pb = (const float4*)(sBB + t * 64 + kp * 8);
            const float4* pq = (const float4*)(sK + t * 64 + kp * 8); const float4* pr = (const float4*)(sR + t * 64 + kp * 8);
            const float4 d0 = pd[0], d1 = pd[1], k0 = pk[0], k1 = pk[1], b0 = pb[0], b1 = pb[1], q0 = pq[0], q1 = pq[1], r0 = pr[0], r1 = pr[1];
            const float vv = sV[t * 64 + vrow];
            float sa = S[0] * k0.x + S[1] * k0.y + S[2] * k0.z + S[3] * k0.w + S[4] * k1.x + S[5] * k1.y + S[6] * k1.z + S[7] * k1.w;
            sa += __shfl_xor(sa, 1); sa += __shfl_xor(sa, 2); sa += __shfl_xor(sa, 4);
            sa = -sa;
            S[0] = S[0] * d0.x + sa * b0.x + vv * q0.x; S[1] = S[1] * d0.y + sa * b0.y + vv * q0.y; S[2] = S[2] * d0.z + sa * b0.z + vv * q0.z; S[3] = S[3] * d0.w + sa * b0.w + vv * q0.w;
            S[4] = S[4] * d1.x + sa * b1.x + vv * q1.x; S[5] = S[5] * d1.y + sa * b1.y + vv * q1.y; S[6] = S[6] * d1.z + sa * b1.z + vv * q1.z; S[7] = S[7] * d1.w + sa * b1.w + vv * q1.w;
            float y = S[0] * r0.x + S[1] * r0.y + S[2] * r0.z + S[3] * r0.w + S[4] * r1.x + S[5] * r1.y + S[6] * r1.z + S[7] * r1.w;
            y += __shfl_xor(y, 1); y += __shfl_xor(y, 2); y += __shfl_xor(y, 4);
            if (kp == 0) sY[t * 64 + vrow] = y;
        }
        __syncthreads();
        for (int t = wave; t < nt; t += 8) {
            const int c = lane, cg = 64 * h + c;
            const float y = sY[t * 64 + c];
            const float mean = wave_sum(y) * (1.f / 64.f);
            const float d = y - mean;
            const float var = wave_sum(d * d) * (1.f / 64.f);
            const float yn = d * rsqrtf(var + 64e-5f) * ln_g[cg] + ln_b[cg];
            const float o = (yn + sBonus[t] * sV[t * 64 + c]) * sG[t * 64 + c];
            OA[((size_t)row0 + t0 + t) * 512 + cg] = f2bf(o);
        }
        __syncthreads();
    }
    float* so = S_out + vrow * 64 + kp * 8;
    *(float4*)so = make_float4(S[0], S[1], S[2], S[3]); *(float4*)(so + 4) = make_float4(S[4], S[5], S[6], S[7]);
}

__device__ void hgrn_seq_item(const Params& p, unsigned char* lds, int row0, int T, int h, const float* __restrict__ S_init, float* __restrict__ S_out) {
    float* sF = (float*)lds; float* sQ = sF + 4096; float* sI = sQ + 4096; float* sO = sI + 4096;
    const int tid = threadIdx.x, lane = tid & 63, wave = tid >> 6, col = tid >> 2, kp = tid & 3;
    const float* F = (const float*)(p.ws + WS_F); const bf16_t* QS = (const bf16_t*)(p.ws + WS_QS); const bf16_t* HI = (const bf16_t*)(p.ws + WS_HI);
    const bf16_t* OG = (const bf16_t*)(p.ws + WS_OG); bf16_t* OB = (bf16_t*)(p.ws + WS_OB); const float* norm_g = p.in[20];
    float S[32];
#pragma unroll
    for (int j = 0; j < 32; ++j) S[j] = S_init ? S_init[(32 * kp + j) * 128 + col] : 0.f;
    __syncthreads();
    for (int t0 = 0; t0 < T; t0 += 32) {
        const int nt = (T - t0) < 32 ? (T - t0) : 32;
        for (int idx = tid; idx < nt * 128; idx += NTHR) { const int t = idx >> 7, c = idx & 127; const size_t o = ((size_t)row0 + t0 + t) * 512 + 128 * h + c;
            sF[idx] = F[o]; sQ[idx] = bf2f(QS[o]); sI[idx] = bf2f(HI[o]); }
        __syncthreads();
        for (int t = 0; t < nt; ++t) {
            const float iv = sI[t * 128 + col]; float o = 0.f;
#pragma unroll
            for (int j4 = 0; j4 < 8; ++j4) {
                const float4 f = *(const float4*)(sF + t * 128 + 32 * kp + 4 * j4), q = *(const float4*)(sQ + t * 128 + 32 * kp + 4 * j4);
                S[4 * j4 + 0] = f.x * S[4 * j4 + 0] + (1.f - f.x) * iv; o += q.x * S[4 * j4 + 0];
                S[4 * j4 + 1] = f.y * S[4 * j4 + 1] + (1.f - f.y) * iv; o += q.y * S[4 * j4 + 1];
                S[4 * j4 + 2] = f.z * S[4 * j4 + 2] + (1.f - f.z) * iv; o += q.z * S[4 * j4 + 2];
                S[4 * j4 + 3] = f.w * S[4 * j4 + 3] + (1.f - f.w) * iv; o += q.w * S[4 * j4 + 3];
            }
            o += __shfl_xor(o, 1); o += __shfl_xor(o, 2);
            if (kp == 0) sO[t * 128 + col] = o;
        }
        __syncthreads();
        for (int t = wave; t < nt; t += 8) {
            const float o1 = sO[t * 128 + lane], o2 = sO[t * 128 + 64 + lane];
            const float ss = wave_sum(o1 * o1 + o2 * o2);
            const float rstd = rsqrtf(ss * (1.f / 128.f) + 1e-6f);
            const size_t o = ((size_t)row0 + t0 + t) * 512 + 128 * h + lane;
            OB[o] = f2bf(o1 * rstd * norm_g[128 * h + lane] * bf2f(OG[o]));
            OB[o + 64] = f2bf(o2 * rstd * norm_g[128 * h + 64 + lane] * bf2f(OG[o + 64]));
        }
        __syncthreads();
    }
#pragma unroll
    for (int j = 0; j < 32; ++j) S_out[(32 * kp + j) * 128 + col] = S[j];
}

__device__ void phase_mix_seq(const Params& p, unsigned char* lds) {
    const int blk = blockIdx.x;
    float* out = p.out;
    if (blk < 64) { const int b = blk >> 3, h = blk & 7; rwkv_seq_item(p, lds, b * SEQ, SEQ, h, nullptr, nullptr, out + O_WKVP + (size_t)(b * 8 + h) * 4096); }
    else if (blk < 96) { const int i = blk - 64, b = i >> 2, h = i & 3; hgrn_seq_item(p, lds, b * SEQ, SEQ, h, nullptr, out + O_HGP + (size_t)(b * 4 + h) * 16384); }
    else {
        const int nb = gridDim.x - 96;
        for (int it = blk - 96; it < 1536; it += nb) {
            if (it < 1024) { const int b = it >> 3, h = it & 7;
                rwkv_seq_item(p, lds, TP + b, 1, h, p.in[2] + (size_t)(b * 8 + h) * 4096, p.in[3] + (size_t)b * RP, out + O_WKVS + (size_t)(b * 8 + h) * 4096); }
            else { const int j = it - 1024, b = j >> 2, h = j & 3;
                hgrn_seq_item(p, lds, TP + b, 1, h, p.in[4] + (size_t)(b * 4 + h) * 16384, out + O_HGS + (size_t)(b * 4 + h) * 16384); }
        }
    }
}

__device__ void phase_final_norm(const Params& p) {
    const int lane = threadIdx.x & 63, wave = threadIdx.x >> 6;
    const float* g = p.in[27];
    for (int row = blockIdx.x * 8 + wave; row < M; row += gridDim.x * 8) {
        float* x = p.out + (size_t)row * D;
        float4 v[4]; float ss = 0.f;
#pragma unroll
        for (int i = 0; i < 4; ++i) { v[i] = *(const float4*)(x + i * 256 + lane * 4); ss += v[i].x * v[i].x + v[i].y * v[i].y + v[i].z * v[i].z + v[i].w * v[i].w; }
        ss = wave_sum(ss);
        const float rstd = rsqrtf(ss * (1.f / D) + 1e-6f);
#pragma unroll
        for (int i = 0; i < 4; ++i) { const float4 gg = *(const float4*)(g + i * 256 + lane * 4);
            *(float4*)(x + i * 256 + lane * 4) = make_float4(v[i].x * rstd * gg.x, v[i].y * rstd * gg.y, v[i].z * rstd * gg.z, v[i].w * rstd * gg.w); }
    }
}

#ifndef COOP
#define COOP 0
#endif
constexpr int NPHASE = 8;
template <int MASK> __global__ void __launch_bounds__(NTHR) fwd_kernel(Params p) {
    extern __shared__ __attribute__((aligned(16))) unsigned char lds[];
    PG8_LAS unsigned char* l3 = (PG8_LAS unsigned char*)lds;
    unsigned char* ws = p.ws;
    const int G = gridDim.x, c = blockIdx.x;
    bf16_t* GATE = (bf16_t*)p.out;
    float* ssq = (float*)(ws + WS_MISC + 4096);
    for (int ph = p.ph_lo; ph < p.ph_hi; ++ph) {
        if ((MASK & 1) && ph == 0) phase_prep(p, lds);
        else if ((MASK & 2) && ph == 1) {
            pg8::Gemm g{(const bf16_t*)(ws + WS_H), (const bf16_t*)(ws + WS_BTIN), MPAD, NIN, D}; pg8::StaticOrder S; S.init(MPAD, NIN, G, c);
            EpiIn E{(bf16_t*)(ws + WS_PR), (bf16_t*)(ws + WS_QS), (float*)(ws + WS_F), (bf16_t*)(ws + WS_HI), (bf16_t*)(ws + WS_OG), GATE, (const float*)(ws + WS_MISC), p.out + O_SHP, p.out + O_SHS};
            pg8::gemm_phase<EpiIn, pg8::StaticOrder>(l3, g, S, E);
        } else if ((MASK & 4) && ph == 2) phase_mix_seq(p, lds);
        else if ((MASK & 8) && ph == 3) {
            pg8::StaticOrder S; S.init(MPAD, D, G, c);
            { pg8::Gemm g{(const bf16_t*)(ws + WS_OA), (const bf16_t*)(ws + WS_BTUPA), MPAD, D, 512}; EpiMerge<false> E{(bf16_t*)(ws + WS_MG), GATE}; pg8::gemm_phase<EpiMerge<false>, pg8::StaticOrder>(l3, g, S, E); }
            __syncthreads();
            { pg8::Gemm g{(const bf16_t*)(ws + WS_OB), (const bf16_t*)(ws + WS_BTUPB), MPAD, D, 512}; EpiMerge<true> E{(bf16_t*)(ws + WS_MG), GATE}; pg8::gemm_phase<EpiMerge<true>, pg8::StaticOrder>(l3, g, S, E); }
        } else if ((MASK & 16) && ph == 4) {
            pg8::Gemm g{(const bf16_t*)(ws + WS_MG), (const bf16_t*)(ws + WS_BTOUT), MPAD, D, D}; pg8::StaticOrder S; S.init(MPAD, D, G, c);
            EpiOut E{p.in[0], p.in[1], p.out, (bf16_t*)(ws + WS_X1B), ssq};
            pg8::gemm_phase<EpiOut, pg8::StaticOrder>(l3, g, S, E);
        } else if ((MASK & 32) && ph == 5) {
            pg8::Gemm g{(const bf16_t*)(ws + WS_X1B), (const bf16_t*)(ws + WS_BTGU), MPAD, 2 * DFF, D}; pg8::StaticOrder S; S.init(MPAD, 2 * DFF, G, c);
            EpiGU E{(bf16_t*)(ws + WS_ACT), ssq};
            pg8::gemm_phase<EpiGU, pg8::StaticOrder>(l3, g, S, E);
        } else if ((MASK & 64) && ph == 6) {
            pg8::Gemm g{(const bf16_t*)(ws + WS_ACT), (const bf16_t*)(ws + WS_BTDN), MPAD, D, DFF}; pg8::StaticOrder S; S.init(MPAD, D, G, c);
            EpiDown E{p.out};
            pg8::gemm_phase<EpiDown, pg8::StaticOrder>(l3, g, S, E);
        } else if ((MASK & 128) && ph == 7) phase_final_norm(p);
#if COOP
        if (ph + 1 < p.ph_hi) cg::this_grid().sync();
#endif
    }
}

#if COOP
constexpr int NKERN = 1;
static const void* kern_ptr(int) { return (const void*)fwd_kernel<255>; }
#else
constexpr int NKERN = 8;
static const void* kern_ptr(int k) {
    switch (k) { case 0: return (const void*)fwd_kernel<1>; case 1: return (const void*)fwd_kernel<2>; case 2: return (const void*)fwd_kernel<4>; case 3: return (const void*)fwd_kernel<8>;
                 case 4: return (const void*)fwd_kernel<16>; case 5: return (const void*)fwd_kernel<32>; case 6: return (const void*)fwd_kernel<64>; default: return (const void*)fwd_kernel<128>; }
}
#endif
extern "C" void kernel_launch(void* const* d_in, const int* in_sizes, int n_in, void* d_out, int out_size, void* d_ws, size_t ws_size, hipStream_t stream) {
    static int grid = 0;
    if (grid == 0) {
        if (n_in != 28 || ws_size < WS_END) { fprintf(stderr, "kernel_launch: unexpected n_in %d / ws_size %zu (need %zu)\n", n_in, ws_size, (size_t)WS_END); grid = -1; return; }
        for (int k = 0; k < NKERN; ++k) if (hipFuncSetAttribute(kern_ptr(k), hipFuncAttributeMaxDynamicSharedMemorySize, LDS_BYTES) != hipSuccess) { fprintf(stderr, "kernel_launch: hipFuncSetAttribute failed\n"); grid = -1; return; }
        int dev = 0, cus = 0, per_cu = 0;
        (void)hipGetDevice(&dev); (void)hipDeviceGetAttribute(&cus, hipDeviceAttributeMultiprocessorCount, dev);
        (void)hipOccupancyMaxActiveBlocksPerMultiprocessor(&per_cu, kern_ptr(0), NTHR, LDS_BYTES);
        if (per_cu < 1) { fprintf(stderr, "kernel_launch: occupancy query says %d blocks per CU\n", per_cu); per_cu = 1; }
        grid = cus;
        (void)hipGetLastError();
    }
    if (grid < 0) return;
    Params p{};
    for (int i = 0; i < 28; ++i) p.in[i] = (const float*)d_in[i];
    p.out = (float*)d_out; p.ws = (unsigned char*)d_ws;
#if COOP
    p.ph_lo = 0; p.ph_hi = NPHASE;
    void* args[] = {&p};
    hipError_t e = hipLaunchCooperativeKernel(kern_ptr(0), dim3(grid), dim3(NTHR), args, LDS_BYTES, stream);
    if (e != hipSuccess) fprintf(stderr, "cooperative launch failed: %s (grid %d)\n", hipGetErrorString(e), grid);
#else
    for (int ph = 0; ph < NPHASE; ++ph) { p.ph_lo = ph; p.ph_hi = ph + 1; void* args[] = {&p}; (void)hipLaunchKernel(kern_ptr(ph), dim3(grid), dim3(NTHR), args, LDS_BYTES, stream); }
#endif
}
```

```cpp
#include <hip/hip_runtime.h>
#include <hip/hip_cooperative_groups.h>
#include <cstdio>
namespace cg = cooperative_groups;
__device__ __forceinline__ int tidx() { int t = __builtin_amdgcn_workitem_id_x(); asm volatile("" : "+v"(t)); return t; }
namespace pg8 {
#define PG8_LAS __attribute__((address_space(3)))
typedef unsigned short bf16_t;
typedef short bf16x8 __attribute__((ext_vector_type(8)));
typedef float f32x4 __attribute__((ext_vector_type(4)));
typedef unsigned u32x4 __attribute__((ext_vector_type(4)));
constexpr int BM = 256, BK = 64, HALF = 128, HTB = HALF * BK * 2  , STAGE_BYTES = 8 * HTB, NXCD = 8, WGM = 8;

__host__ __device__ __forceinline__ int lds_byte(int r, int c) { const int st = (r >> 4) * 2 + (c >> 5), rr = r & 15, cc = c & 31, ob = rr * 64 + cc * 2; return st * 1024 + (ob ^ (((ob >> 9) & 1) << 5)); }
__host__ __device__ __forceinline__ void stage_rc(int b, int& R, int& C) { const int st = b / 1024, sb = b % 1024, swz = sb ^ (((sb >> 9) & 1) << 5); R = (st >> 1) * 16 + swz / 64; C = (st & 1) * 32 + (swz % 64) / 2; }
__host__ __device__ __forceinline__ int perm32(int rho) { const int n = rho >> 4, i = rho & 15; return 8 * (i >> 2) + 4 * n + (i & 3); }

struct Unit { int pm, pn; };
struct Gemm { const bf16_t* A; const bf16_t* Bt; int M, N, K; };

struct StaticOrder {
    int nM, nN, nwg, G, c;
    __host__ __device__ void init(int M, int N, int G_, int c_) { nM = M / BM; nN = N / BM; nwg = nM * nN; G = G_; c = c_; }
    __host__ __device__ bool next(int i, Unit& u) const {
        const long L = (long)i * G + c; if (L >= nwg) return false;
        int wgid = (int)L; { const int q = nwg / NXCD, r = nwg % NXCD, xcd = wgid % NXCD, off = wgid / NXCD; wgid = (xcd < r ? xcd * (q + 1) : r * (q + 1) + (xcd - r) * q) + off; }
        const int nig = WGM * nN, gid = wgid / nig, fm = gid * WGM, gsz = (nM - fm) < WGM ? (nM - fm) : WGM;
        u.pm = fm + ((wgid % nig) % gsz); u.pn = (wgid % nig) / gsz; return true;
    }
    __device__ __forceinline__ void a_ready(const Unit&) const {}
    __device__ __forceinline__ void done(const Unit&) const {}
};
typedef float f32x2 __attribute__((ext_vector_type(2)));
typedef __bf16 bf16x2n __attribute__((ext_vector_type(2)));
__device__ __forceinline__ unsigned cvt_pk_bf16(float lo, float hi) { const f32x2 v = {lo, hi}; return __builtin_bit_cast(unsigned, __builtin_convertvector(v, bf16x2n)); }
template <class Epi, class Sched>
__device__ __forceinline__ void gemm_phase(PG8_LAS unsigned char* lds, const Gemm g, const Sched& S, const Epi& E) {
    const int tid = tidx(), wid = __builtin_amdgcn_readfirstlane(tid >> 6), lane = tid & 63, wr = wid >> 2, wc = wid & 3, fr = lane & 15, fq = lane >> 4;
    const int K = g.K, nt = K / BK;
    unsigned voffA[2], voffB[2];
#pragma unroll
    for (int i = 0; i < 2; ++i) { int R, C; stage_rc(tid * 16 + i * 8192, R, C); const int Rb = Epi::PERM ? ((R & ~31) + perm32(R & 31)) : R;
        voffA[i] = (unsigned)(R * K + C) * 2u; voffB[i] = (unsigned)(Rb * K + C) * 2u; }
    const size_t kstep = (size_t)(BK * 2);
    const size_t hstep = (size_t)HALF * K * 2;
    const size_t tstep = 2 * hstep;
    const unsigned ldsw = (unsigned)wid * 1024u;
    const int aoff = lds_byte(wr * 64 + fr, fq * 8), boff = lds_byte(wc * 32 + fr, fq * 8);
#define PG8_SA(b, h) (((b) * 2 + (h)) * HTB)
#define PG8_SB(b, h) ((4 + (b) * 2 + (h)) * HTB)
#define PG8_STAGE(bufoff, gbase, voff) do { _Pragma("unroll") for (int _i = 0; _i < 2; ++_i) \
        __builtin_amdgcn_global_load_lds((const unsigned*)((const char*)(gbase) + (voff)[_i]), (PG8_LAS unsigned*)(lds + (bufoff) + ldsw + _i * 8192), 16, 0, 0); } while (0)
#define PG8_LDA(dst, b, h) do { _Pragma("unroll") for (int m = 0; m < 4; ++m) _Pragma("unroll") for (int k = 0; k < 2; ++k) dst[m][k] = *(const PG8_LAS bf16x8*)(lds + PG8_SA(b, h) + aoff + m * 2048 + k * 1024); } while (0)
#define PG8_LDB(dst, b, h) do { _Pragma("unroll") for (int n = 0; n < 2; ++n) _Pragma("unroll") for (int k = 0; k < 2; ++k) dst[n][k] = *(const PG8_LAS bf16x8*)(lds + PG8_SB(b, h) + boff + n * 2048 + k * 1024); } while (0)
#define PG8_MMA(ai, bj, At, Bt) do { __builtin_amdgcn_s_setprio(1); _Pragma("unroll") for (int m = 0; m < 4; ++m) _Pragma("unroll") for (int n = 0; n < 2; ++n) _Pragma("unroll") for (int k = 0; k < 2; ++k) \
        acc[ai][bj][m][n] = __builtin_amdgcn_mfma_f32_16x16x32_bf16(Bt[n][k], At[m][k], acc[ai][bj][m][n], 0, 0, 0); __builtin_amdgcn_s_setprio(0); } while (0)
#define PG8_WAIT_V(n) asm volatile("s_waitcnt vmcnt(" #n ")" ::: "memory")
#define PG8_WAIT_L(n) asm volatile("s_waitcnt lgkmcnt(" #n ")" ::: "memory")
#define PG8_BAR __builtin_amdgcn_s_barrier()
#define PG8_SCHED __builtin_amdgcn_sched_barrier(0)
    Unit cur, nxt; int ui = 0;
    if (!S.next(0, cur)) return;
    f32x4 acc[2][2][4][2];
#pragma unroll
    for (int a = 0; a < 2; ++a)
#pragma unroll
        for (int b = 0; b < 2; ++b)
#pragma unroll
            for (int m = 0; m < 4; ++m)
#pragma unroll
                for (int n = 0; n < 2; ++n) acc[a][b][m][n] = (f32x4){0.f, 0.f, 0.f, 0.f};
    bf16x8 At[4][2], B0[2][2], B1[2][2];
    const char* cA = (const char*)g.A + (size_t)cur.pm * tstep; const char* cB = (const char*)g.Bt + (size_t)cur.pn * tstep;
    S.a_ready(cur);
    PG8_STAGE(PG8_SB(0, 0), cB, voffB); PG8_STAGE(PG8_SA(0, 0), cA, voffA); PG8_STAGE(PG8_SB(0, 1), cB + hstep, voffB); PG8_STAGE(PG8_SA(0, 1), cA + hstep, voffA);
    if (wr == 1) PG8_BAR;
    PG8_WAIT_V(4); PG8_BAR;
    PG8_STAGE(PG8_SB(1, 0), cB + kstep, voffB); PG8_STAGE(PG8_SA(1, 0), cA + kstep, voffA); PG8_STAGE(PG8_SB(1, 1), cB + hstep + kstep, voffB);
    PG8_WAIT_V(6); PG8_BAR;
    for (;;) {
        const bool has_next = S.next(ui + 1, nxt);
        const char* nA = has_next ? (const char*)g.A + (size_t)nxt.pm * tstep : cA; const char* nB = has_next ? (const char*)g.Bt + (size_t)nxt.pn * tstep : cB;
        for (int t = 0; t < nt; t += 2) {
            const bool last = (t == nt - 2);
            const char* a1 = cA + (size_t)(t + 1) * kstep;
            const char* a2 = last ? nA : cA + (size_t)(t + 2) * kstep; const char* b2 = last ? nB : cB + (size_t)(t + 2) * kstep;
            const char* a3 = a2 + kstep; const char* b3 = b2 + kstep;
            if (last && has_next) S.a_ready(nxt);
            PG8_LDB(B0, 0, 0); PG8_SCHED; PG8_LDA(At, 0, 0); PG8_STAGE(PG8_SA(1, 1), a1 + hstep, voffA);
            PG8_WAIT_L(8); PG8_BAR; PG8_WAIT_L(0); PG8_MMA(0, 0, At, B0); PG8_BAR; PG8_SCHED;
            PG8_LDB(B1, 0, 1); PG8_STAGE(PG8_SB(0, 0), b2, voffB);
            PG8_BAR; PG8_WAIT_L(0); PG8_MMA(0, 1, At, B1); PG8_BAR;
            PG8_LDA(At, 0, 1); PG8_STAGE(PG8_SA(0, 0), a2, voffA);
            PG8_BAR; PG8_WAIT_L(0); PG8_MMA(1, 0, At, B0); PG8_BAR; PG8_SCHED;
            PG8_STAGE(PG8_SB(0, 1), b2 + hstep, voffB);
            PG8_WAIT_V(6); PG8_BAR; PG8_MMA(1, 1, At, B1); PG8_BAR;
            PG8_LDB(B0, 1, 0); PG8_SCHED; PG8_LDA(At, 1, 0); PG8_STAGE(PG8_SA(0, 1), a2 + hstep, voffA);
            PG8_WAIT_L(8); PG8_BAR; PG8_WAIT_L(0); PG8_MMA(0, 0, At, B0); PG8_BAR; PG8_SCHED;
            PG8_LDB(B1, 1, 1); PG8_STAGE(PG8_SB(1, 0), b3, voffB);
            PG8_BAR; PG8_WAIT_L(0); PG8_MMA(0, 1, At, B1); PG8_BAR;
            PG8_LDA(At, 1, 1); PG8_STAGE(PG8_SA(1, 0), a3, voffA);
            PG8_BAR; PG8_WAIT_L(0); PG8_MMA(1, 0, At, B0); PG8_BAR; PG8_SCHED;
            PG8_STAGE(PG8_SB(1, 1), b3 + hstep, voffB);
            PG8_WAIT_V(6); PG8_BAR; PG8_MMA(1, 1, At, B1); PG8_BAR;
        }
        if constexpr (!Epi::AFTER_DRAIN) { E(acc, cur, wr, wc, fr, fq); S.done(cur); }
        if (!has_next) break;
#pragma unroll
        for (int a = 0; a < 2; ++a)
#pragma unroll
            for (int b = 0; b < 2; ++b)
#pragma unroll
                for (int m = 0; m < 4; ++m)
#pragma unroll
                    for (int n = 0; n < 2; ++n) acc[a][b][m][n] = (f32x4){0.f, 0.f, 0.f, 0.f};
        cur = nxt; cA = nA; cB = nB; ++ui;
    }
    PG8_WAIT_V(0);
    if (wr == 0) PG8_BAR;
    PG8_BAR;
    if constexpr (Epi::AFTER_DRAIN) { E.fused(acc, cur, wr, wc, fr, fq, lds, wid, lane); S.done(cur); }
#undef PG8_SA
#undef PG8_SB
#undef PG8_STAGE
#undef PG8_LDA
#undef PG8_LDB
#undef PG8_MMA
#undef PG8_WAIT_V
#undef PG8_WAIT_L
#undef PG8_BAR
#undef PG8_SCHED
}
}


using pg8::bf16_t; using pg8::bf16x8; using pg8::f32x4; using pg8::u32x4; using pg8::Unit; using pg8::cvt_pk_bf16;
typedef unsigned u32x2 __attribute__((ext_vector_type(2)));

constexpr int D = 1024, TP = 16384, TSMP = 128, M = TP + TSMP, MPAD = 16640, SEQ = 2048;
constexpr int RP = 1792, NIN = 5888, DFF = 2816;
constexpr int NTHR = 512;
constexpr int LDS_BYTES = 140 * 1024;

constexpr size_t O_Y = 0, O_WKVP = (size_t)M * D, O_SHP = O_WKVP + 8 * 8 * 64 * 64, O_HGP = O_SHP + 8 * RP,
                 O_WKVS = O_HGP + 8 * 4 * 128 * 128, O_SHS = O_WKVS + (size_t)128 * 8 * 64 * 64, O_HGS = O_SHS + 128 * RP;
constexpr size_t WS_BTIN = 0, WS_BTUPA = WS_BTIN + (size_t)NIN * D * 2, WS_BTUPB = WS_BTUPA + (size_t)D * 512 * 2, WS_BTOUT = WS_BTUPB + (size_t)D * 512 * 2,
                 WS_BTGU = WS_BTOUT + (size_t)D * D * 2, WS_BTDN = WS_BTGU + (size_t)2 * DFF * D * 2, WS_MISC = WS_BTDN + (size_t)D * DFF * 2,
                 WS_H = WS_MISC + 262144, WS_PR = WS_H + (size_t)MPAD * D * 2, WS_QS = WS_PR + (size_t)MPAD * RP * 2, WS_F = WS_QS + (size_t)MPAD * 512 * 2,
                 WS_HI = WS_F + (size_t)MPAD * 512 * 4, WS_OG = WS_HI + (size_t)MPAD * 512 * 2, WS_OA = WS_OG + (size_t)MPAD * 512 * 2,
                 WS_OB = WS_OA + (size_t)MPAD * 512 * 2, WS_END = WS_OB + (size_t)MPAD * 512 * 2;
constexpr size_t WS_MG = WS_H, WS_ACT = WS_PR, WS_X1B = WS_OA;
constexpr size_t WS_ACTS = WS_END, WS_X1BS = WS_ACTS + (size_t)256 * DFF * 2, WS_END2 = WS_X1BS + (size_t)256 * D * 2;
constexpr size_t WS_SUBBAR = WS_MISC + 196608;
constexpr size_t WS_XBAR2 = WS_MISC + 229376;
constexpr size_t WS_XBAR = WS_MISC + 212992;
constexpr size_t WS_LIN = WS_OA;
constexpr size_t WS_LD = WS_H, WS_AA = WS_H + (size_t)MPAD * 512 * 2;
constexpr size_t WS_GG = WS_END2, WS_MGS = WS_GG + (size_t)MPAD * 512 * 2, WS_BTLO = WS_MGS + (size_t)256 * D * 2, WS_END3 = WS_BTLO + (size_t)1536 * 256 * 2;
constexpr size_t WS_BON = WS_END3, WS_END4 = WS_BON + (size_t)TP * 8 * 4;
static_assert(WS_END4 <= (size_t)256 * 1024 * 1024, "workspace 4");
static_assert((size_t)MPAD * DFF * 2 <= WS_OA - WS_PR, "ACT alias");
static_assert(WS_END2 <= (size_t)256 * 1024 * 1024, "workspace");

struct Params {
    const float* in[28];
    float* out;
    unsigned char* ws;
    int pad0, pad1;
};


#define XB_TMO      128
#define XB_XCNT(j)  (256  + 64 * (j))
#define XB_XSUB(j)  (1280 + 64 * (j))
#define XB_XGEN(j)  (2304 + 64 * (j))
#define XB_TOP      3328
#define XB_TOPGEN   3392
#define XCD_BAR_WORDS 3456
#define XB_SPIN_CAP (1u << 18)
#ifndef LAS
#define LAS __attribute__((address_space(3)))
#endif

__device__ __forceinline__ unsigned xb_ld(unsigned* p)              { return __hip_atomic_load(p, __ATOMIC_RELAXED, __HIP_MEMORY_SCOPE_AGENT); }
__device__ __forceinline__ unsigned xb_add(unsigned* p, unsigned v) { return __hip_atomic_fetch_add(p, v, __ATOMIC_RELAXED, __HIP_MEMORY_SCOPE_AGENT); }
__device__ __forceinline__ unsigned xb_xcc_id() { return (unsigned)__builtin_amdgcn_s_getreg((3 << 11) | 20) & 0xFu; }
#define XB_SPIN(cond, bar) do { unsigned _sp = 0; while (cond) { __builtin_amdgcn_s_sleep(1); \
    if ((++_sp & 255u) == 0u) { if (xb_ld(&(bar)[XB_TMO])) break; if (_sp > XB_SPIN_CAP) { atomicAdd(&(bar)[XB_TMO], 1u); break; } } } } while (0)

struct XcdBarrier {
    unsigned nexp;
    unsigned* bar; unsigned x;
    volatile LAS unsigned* st;
};

__device__ __forceinline__ XcdBarrier xcd_barrier_post(unsigned* bar, volatile LAS unsigned* st, unsigned nexp) {
    XcdBarrier b; b.nexp = nexp; b.bar = bar; b.x = xb_xcc_id(); b.st = st;
    if (threadIdx.x == 0) (void)xb_add(&bar[XB_XCNT(b.x)], 1u);
    return b;
}
__device__ __forceinline__ void xcd_barrier_complete(unsigned* bar, unsigned x, unsigned& nloc, unsigned& nx, unsigned G) {
    unsigned sum, cnt, mine, sp = 0u;
    for (;;) {
        sum = 0u; cnt = 0u; mine = 0u;
#pragma unroll
        for (unsigned j = 0; j < 16; ++j) { const unsigned c = xb_ld(&bar[XB_XCNT(j)]); sum += c; cnt += (c > 0u) ? 1u : 0u; mine = (j == x) ? c : mine; }
        if (sum == G) break;
        __builtin_amdgcn_s_sleep(1);
        if ((++sp & 255u) == 0u) { if (xb_ld(&bar[XB_TMO])) break; if (sp > XB_SPIN_CAP) { atomicAdd(&bar[XB_TMO], 1u); break; } }
    }
    nloc = mine > 0u ? mine : 1u; nx = cnt > 0u ? cnt : 1u;
}

__device__ __forceinline__ void xcd_barrier(const XcdBarrier& b) {
    asm volatile("s_waitcnt vmcnt(0)" ::: "memory");
    __syncthreads();
    if (threadIdx.x == 0) {
        unsigned* bar = b.bar;
        __builtin_amdgcn_s_waitcnt(0);
        unsigned nloc = b.st[0], nx = b.st[1];
        if (nloc == 0u) { xcd_barrier_complete(bar, b.x, nloc, nx, b.nexp); b.st[0] = nloc; b.st[1] = nx; }
        const unsigned old = xb_add(&bar[XB_XSUB(b.x)], 1u);
        const unsigned gen = old / nloc;
        if (old + 1u == (gen + 1u) * nloc) {
            __builtin_amdgcn_fence(__ATOMIC_RELEASE, "agent");
            asm volatile("s_waitcnt vmcnt(0)" ::: "memory");
            const unsigned og = xb_add(&bar[XB_TOP], 1u);
            const unsigned tg = og / nx;
            if (og + 1u == (tg + 1u) * nx) xb_add(&bar[XB_TOPGEN], 1u);
            else XB_SPIN(xb_ld(&bar[XB_TOPGEN]) == tg, bar);
            __builtin_amdgcn_fence(__ATOMIC_ACQUIRE, "agent");
            xb_add(&bar[XB_XGEN(b.x)], 1u);
            asm volatile("s_waitcnt vmcnt(0)" ::: "memory");
        } else {
            XB_SPIN(xb_ld(&bar[XB_XGEN(b.x)]) == gen, bar);
            __builtin_amdgcn_fence(__ATOMIC_ACQUIRE, "agent");
            asm volatile("s_waitcnt vmcnt(0)" ::: "memory");
        }
    }
    __syncthreads();
}


__device__ __attribute__((noinline)) void xcd_barrier_call(unsigned* bar, unsigned x, volatile LAS unsigned* st, unsigned nexp) { XcdBarrier b; b.nexp = nexp; b.bar = bar; b.x = x; b.st = st; xcd_barrier(b); }

constexpr int PARAMS_OFF = LDS_BYTES - 512;
__device__ __forceinline__ unsigned long long ld_u64_uniform(const unsigned char* lds, int i) {
    const unsigned long long v = ((const unsigned long long*)(lds + PARAMS_OFF))[i];
    const unsigned lo = __builtin_amdgcn_readfirstlane((unsigned)v), hi = __builtin_amdgcn_readfirstlane((unsigned)(v >> 32));
    return ((unsigned long long)hi << 32) | lo;
}
__device__ __forceinline__ Params load_params(const unsigned char* lds) {
    Params q;
#pragma unroll
    for (int i = 0; i < 28; ++i) q.in[i] = (const float*)(const __attribute__((address_space(1))) float*)ld_u64_uniform(lds, i);
    q.out = (float*)(__attribute__((address_space(1))) float*)ld_u64_uniform(lds, 28); q.ws = (unsigned char*)(__attribute__((address_space(1))) unsigned char*)ld_u64_uniform(lds, 29); q.pad0 = 0; q.pad1 = 0;
    return q;
}

__device__ __forceinline__ float sigmoidf_(float x) { return __builtin_amdgcn_rcpf(1.f + __expf(-x)); }
__device__ __forceinline__ float bf2f(bf16_t v) { return __uint_as_float(((unsigned)v) << 16); }
__device__ __forceinline__ bf16_t f2bf(float f) { unsigned u = __float_as_uint(f); u += 0x7FFFu + ((u >> 16) & 1u); return (bf16_t)(u >> 16); }
template <int CTRL> __device__ __forceinline__ float dppf(float v) { return __builtin_bit_cast(float, __builtin_amdgcn_update_dpp(0, __builtin_bit_cast(int, v), CTRL, 0xF, 0xF, true)); }
__device__ __forceinline__ float red8(float v) { v += dppf<0xB1>(v); v += dppf<0x4E>(v); v += dppf<0x141>(v); return v; }
__device__ __forceinline__ float red16(float v) { v = red8(v); v += dppf<0x140>(v); return v; }
__device__ __forceinline__ float rdl(float v, int l) { return __builtin_bit_cast(float, __builtin_amdgcn_readlane(__builtin_bit_cast(int, v), l)); }
__device__ __forceinline__ float wave_sum(float v) { v = red16(v); return (rdl(v, 0) + rdl(v, 16)) + (rdl(v, 32) + rdl(v, 48)); }
__device__ __forceinline__ float fast_tanh(float x) { return 1.f - 2.f * __builtin_amdgcn_rcpf(1.f + __expf(2.f * x)); }
typedef float f2 __attribute__((ext_vector_type(2)));

struct TileDesc { const float* src; const float* kscale; bf16_t* dst; int K, N, kt, nt, mode; };
__device__ __forceinline__ TileDesc tile_desc(const Params& p, int t) {
    unsigned char* ws = p.ws; TileDesc d; d.kscale = nullptr; d.mode = 0;
    if (t < 1472) { d.src = p.in[6]; d.K = D; d.N = NIN; d.kt = t / 92; d.nt = t % 92; d.dst = (bf16_t*)(ws + WS_BTIN); }
    else if (t < 1600) { const int u = t - 1472; d.src = p.in[18]; d.K = 512; d.N = D; d.kt = u / 16; d.nt = u % 16; d.dst = (bf16_t*)(ws + WS_BTUPA); }
    else if (t < 1728) { const int u = t - 1600; d.src = p.in[21]; d.K = 512; d.N = D; d.kt = u / 16; d.nt = u % 16; d.dst = (bf16_t*)(ws + WS_BTUPB); }
    else if (t < 1984) { const int u = t - 1728; d.src = p.in[22]; d.K = D; d.N = D; d.kt = u / 16; d.nt = u % 16; d.dst = (bf16_t*)(ws + WS_BTOUT); }
    else if (t < 2688) { const int u = t - 1984; d.src = p.in[24]; d.K = D; d.N = DFF; d.kt = u / 44; d.nt = u % 44; d.dst = (bf16_t*)(ws + WS_BTGU); d.mode = 1; d.kscale = p.in[23]; }
    else if (t < 3392) { const int u = t - 2688; d.src = p.in[25]; d.K = D; d.N = DFF; d.kt = u / 44; d.nt = u % 44; d.dst = (bf16_t*)(ws + WS_BTGU); d.mode = 2; d.kscale = p.in[23]; }
    else { const int u = t - 3392; d.src = p.in[26]; d.K = DFF; d.N = D; d.kt = u / 16; d.nt = u % 16; d.dst = (bf16_t*)(ws + WS_BTDN); }
    return d;
}
__device__ void phase_prep(const Params& p, unsigned char* lds) {
    float* tile = (float*)lds;
    unsigned char* ws = p.ws;
    {
        const int tid = tidx(), li = tid >> 3, j0 = (tid & 7) * 8;
        int t = blockIdx.x;
        TileDesc d = tile_desc(p, t < 4096 ? t : 4095);
        const float* s0 = d.src + (size_t)(d.kt * 64 + li) * d.N + d.nt * 64 + j0;
        float4 a = *(const float4*)s0, b = *(const float4*)(s0 + 4);
        float sc = d.kscale ? d.kscale[d.kt * 64 + li] : 1.f;
        for (; t < 4096; t += gridDim.x) {
            const int tn = t + gridDim.x < 4096 ? t + gridDim.x : t;
            const TileDesc dn = tile_desc(p, tn);
            const float* sn = dn.src + (size_t)(dn.kt * 64 + li) * dn.N + dn.nt * 64 + j0;
            const float4 na = *(const float4*)sn, nb = *(const float4*)(sn + 4);
            const float nsc = dn.kscale ? dn.kscale[dn.kt * 64 + li] : 1.f;
            float* tw = tile + li * 65 + j0;
            tw[0] = a.x * sc; tw[1] = a.y * sc; tw[2] = a.z * sc; tw[3] = a.w * sc; tw[4] = b.x * sc; tw[5] = b.y * sc; tw[6] = b.z * sc; tw[7] = b.w * sc;
            asm volatile("s_waitcnt lgkmcnt(0)" ::: "memory"); __builtin_amdgcn_s_barrier(); asm volatile("" ::: "memory");
            {
                const int n = tid >> 3, k0 = (tid & 7) * 8;
                float v[8];
#pragma unroll
                for (int kk = 0; kk < 8; ++kk) v[kk] = tile[(k0 + kk) * 65 + n];
                u32x4 w; w.x = cvt_pk_bf16(v[0], v[1]); w.y = cvt_pk_bf16(v[2], v[3]); w.z = cvt_pk_bf16(v[4], v[5]); w.w = cvt_pk_bf16(v[6], v[7]);
                const int ncol = d.nt * 64 + n;
                const int drow = d.mode == 0 ? ncol : ((ncol >> 7) * 256 + (d.mode == 2 ? 128 : 0) + (ncol & 127));
                *(u32x4*)(d.dst + (size_t)drow * d.K + d.kt * 64 + k0) = w;
            }
            asm volatile("s_waitcnt lgkmcnt(0)" ::: "memory"); __builtin_amdgcn_s_barrier(); asm volatile("" ::: "memory");
            d = dn; a = na; b = nb; sc = nsc;
        }
    }
    const int lane = tidx() & 63, wave = tidx() >> 6;
    const float* g = p.in[5];
    bf16_t* H = (bf16_t*)(ws + WS_H);
    {
        float4 gg[4];
#pragma unroll
        for (int i = 0; i < 4; ++i) gg[i] = *(const float4*)(g + i * 256 + lane * 4);
        int row = blockIdx.x * 8 + wave;
        float4 v[4];
        { const int r0 = row < M ? row : M - 1; const float* x = r0 < TP ? p.in[0] + (size_t)r0 * D : p.in[1] + (size_t)(r0 - TP) * D;
#pragma unroll
          for (int i = 0; i < 4; ++i) v[i] = *(const float4*)(x + i * 256 + lane * 4); }
        for (; row < M; row += gridDim.x * 8) {
            const int rn = row + gridDim.x * 8 < M ? row + gridDim.x * 8 : row;
            const float* xn = rn < TP ? p.in[0] + (size_t)rn * D : p.in[1] + (size_t)(rn - TP) * D;
            float4 nv[4];
#pragma unroll
            for (int i = 0; i < 4; ++i) nv[i] = *(const float4*)(xn + i * 256 + lane * 4);
            float ss = 0.f;
#pragma unroll
            for (int i = 0; i < 4; ++i) ss += v[i].x * v[i].x + v[i].y * v[i].y + v[i].z * v[i].z + v[i].w * v[i].w;
            ss = wave_sum(ss);
            const float rstd = rsqrtf(ss * (1.f / D) + 1e-6f);
#pragma unroll
            for (int i = 0; i < 4; ++i) { u32x2 w; w.x = cvt_pk_bf16(v[i].x * rstd * gg[i].x, v[i].y * rstd * gg[i].y); w.y = cvt_pk_bf16(v[i].z * rstd * gg[i].z, v[i].w * rstd * gg[i].w);
                *(u32x2*)(H + (size_t)row * D + i * 256 + lane * 4) = w; }
#pragma unroll
            for (int i = 0; i < 4; ++i) v[i] = nv[i];
        }
    }
    float* lb = (float*)(ws + WS_MISC); float* ssq = (float*)(ws + WS_MISC + 4096);
    const int gt = blockIdx.x * NTHR + tidx();
    if (gt < 512) lb[gt] = 1.f / (1.f + __expf(p.in[19][512 + gt] - p.in[19][gt]));
    for (int i = gt; i < MPAD; i += gridDim.x * NTHR) ssq[i] = 0.f;
    if (gt == 0) *(unsigned*)(ws + WS_SUBBAR) = 0u;
    {
        bf16_t* bl = (bf16_t*)(ws + WS_BTLO);
        for (int i = gt; i < 1536 * 256; i += gridDim.x * NTHR) {
            const int n = i >> 8, k = i & 255; float v = 0.f;
            if (n < 512) { if (k < 64) v = p.in[9][k * 512 + n]; }
            else if (n < 1024) { if (k >= 64 && k < 128) v = p.in[11][(k - 64) * 512 + (n - 512)]; }
            else { if (k >= 128) v = p.in[12][(k - 128) * 512 + (n - 1024)]; }
            bl[i] = f2bf(v);
        }
    }
}

typedef const f32x4 (&AccRef)[2][2][4][2];
__device__ __forceinline__ u32x4 pack8(const f32x4 a, const f32x4 b) { u32x4 w; w.x = cvt_pk_bf16(a[0], a[1]); w.y = cvt_pk_bf16(a[2], a[3]); w.z = cvt_pk_bf16(b[0], b[1]); w.w = cvt_pk_bf16(b[2], b[3]); return w; }
__device__ __forceinline__ void unpack8(const u32x4 w, f32x4& a, f32x4& b) {
    a[0] = __uint_as_float(w.x << 16); a[1] = __uint_as_float(w.x & 0xffff0000u); a[2] = __uint_as_float(w.y << 16); a[3] = __uint_as_float(w.y & 0xffff0000u);
    b[0] = __uint_as_float(w.z << 16); b[1] = __uint_as_float(w.z & 0xffff0000u); b[2] = __uint_as_float(w.w << 16); b[3] = __uint_as_float(w.w & 0xffff0000u); }

struct EpiIn {
    static constexpr bool PERM = true, AFTER_DRAIN = false;
    bf16_t* PR; bf16_t* QS; float* F; bf16_t* HI; bf16_t* OG; bf16_t* GATE; const float* lb; float* shp; float* shs;
    __device__ __forceinline__ void operator()(AccRef acc, const Unit& u, int wr, int wc, int fr, int fq) const {
        const int row0 = u.pm * 256 + wr * 64 + fr, cl = wc * 32 + 8 * fq;
        const int pn = u.pn;
#pragma unroll
        for (int ai = 0; ai < 2; ++ai)
#pragma unroll
            for (int m = 0; m < 4; ++m) {
                const int row = row0 + ai * 128 + m * 16;
#pragma unroll
                for (int bj = 0; bj < 2; ++bj) {
                    f32x4 v0 = acc[ai][bj][m][0], v1 = acc[ai][bj][m][1];
                    const int col = pn * 256 + bj * 128 + cl;
                    if (pn < 7) {
                        *(u32x4*)(PR + (size_t)row * RP + col) = pack8(v0, v1);
                        float* sp = nullptr;
                        if (row < TP) { if ((row & (SEQ - 1)) == SEQ - 1) sp = shp + (size_t)(row >> 11) * RP + col; }
                        else if (row < M) sp = shs + (size_t)(row - TP) * RP + col;
                        if (sp) { *(f32x4*)sp = v0; *(f32x4*)(sp + 4) = v1; }
                    } else if (pn < 15) {
                        const int hc = col - RP, ty = (pn - 7) >> 1, cc = hc - ty * 512;
                        if (ty == 0) {
#pragma unroll
                            for (int j = 0; j < 4; ++j) { v0[j] = v0[j] * sigmoidf_(v0[j]); v1[j] = v1[j] * sigmoidf_(v1[j]); }
                            *(u32x4*)(QS + (size_t)row * 512 + cc) = pack8(v0, v1);
                        } else if (ty == 1) {
                            const f32x4 l0 = *(const f32x4*)(lb + cc), l1 = *(const f32x4*)(lb + cc + 4);
#pragma unroll
                            for (int j = 0; j < 4; ++j) { v0[j] = l0[j] + (1.f - l0[j]) * sigmoidf_(v0[j]); v1[j] = l1[j] + (1.f - l1[j]) * sigmoidf_(v1[j]); }
                            *(f32x4*)(F + (size_t)row * 512 + cc) = v0; *(f32x4*)(F + (size_t)row * 512 + cc + 4) = v1;
                        } else if (ty == 2) {
                            *(u32x4*)(HI + (size_t)row * 512 + cc) = pack8(v0, v1);
                        } else {
#pragma unroll
                            for (int j = 0; j < 4; ++j) { v0[j] = sigmoidf_(v0[j]); v1[j] = sigmoidf_(v1[j]); }
                            *(u32x4*)(OG + (size_t)row * 512 + cc) = pack8(v0, v1);
                        }
                    } else {
                        const int gc = col - (RP + 2048);
#pragma unroll
                        for (int j = 0; j < 4; ++j) { v0[j] = sigmoidf_(v0[j]); v1[j] = sigmoidf_(v1[j]); }
                        if (row < M) *(u32x4*)(GATE + (size_t)row * 2048 + gc) = pack8(v0, v1);
                    }
                }
            }
    }
};

template <bool SECOND> struct EpiMerge {
    static constexpr bool PERM = true, AFTER_DRAIN = false;
    bf16_t* MG; const bf16_t* GATE;
    __device__ __forceinline__ void operator()(AccRef acc, const Unit& u, int wr, int wc, int fr, int fq) const {
        const int row0 = u.pm * 256 + wr * 64 + fr, cl = wc * 32 + 8 * fq;
#pragma unroll
        for (int ai = 0; ai < 2; ++ai)
#pragma unroll
            for (int mh = 0; mh < 2; ++mh) {
                u32x4 gv[2][2], pv[2][2];
#pragma unroll
                for (int mm = 0; mm < 2; ++mm) {
                    const int row = row0 + ai * 128 + (2 * mh + mm) * 16, rg = row < M ? row : M - 1;
#pragma unroll
                    for (int bj = 0; bj < 2; ++bj) {
                        const int col = u.pn * 256 + bj * 128 + cl;
                        gv[mm][bj] = *(const u32x4*)(GATE + (size_t)rg * 2048 + (SECOND ? 1024 : 0) + col);
                        if (SECOND) pv[mm][bj] = *(const u32x4*)(MG + (size_t)row * D + col);
                    }
                }
#pragma unroll
                for (int mm = 0; mm < 2; ++mm) {
                    const int m = 2 * mh + mm, row = row0 + ai * 128 + m * 16;
#pragma unroll
                    for (int bj = 0; bj < 2; ++bj) {
                        const int col = u.pn * 256 + bj * 128 + cl;
                        f32x4 g0, g1; unpack8(gv[mm][bj], g0, g1);
                        f32x4 v0 = acc[ai][bj][m][0] * g0, v1 = acc[ai][bj][m][1] * g1;
                        if (SECOND) { f32x4 p0, p1; unpack8(pv[mm][bj], p0, p1); v0 += p0; v1 += p1; }
                        *(u32x4*)(MG + (size_t)row * D + col) = pack8(v0, v1);
                    }
                }
                asm volatile("" ::: "memory");
            }
    }
};

struct EpiOut {
    static constexpr bool PERM = false, AFTER_DRAIN = false;
    const float* xp; const float* xs; float* X1; bf16_t* X1B; float* ssq;
    __device__ __forceinline__ void operator()(AccRef acc, const Unit& u, int wr, int wc, int fr, int fq) const {
        const int row0 = u.pm * 256 + wr * 64 + fr, col0 = u.pn * 256 + wc * 32 + 4 * fq;
#pragma unroll
        for (int ai = 0; ai < 2; ++ai)
#pragma unroll
            for (int mh = 0; mh < 2; ++mh) {
                f32x4 xv[2][2][2];
#pragma unroll
                for (int mm = 0; mm < 2; ++mm) {
                    const int row = row0 + ai * 128 + (2 * mh + mm) * 16, rc = row < M ? row : M - 1;
                    const float* xr = rc < TP ? xp + (size_t)rc * D : xs + (size_t)(rc - TP) * D;
#pragma unroll
                    for (int bj = 0; bj < 2; ++bj)
#pragma unroll
                        for (int n = 0; n < 2; ++n) xv[mm][bj][n] = *(const f32x4*)(xr + col0 + bj * 128 + n * 16);
                }
#pragma unroll
                for (int mm = 0; mm < 2; ++mm) {
                    const int m = 2 * mh + mm, row = row0 + ai * 128 + m * 16;
                    const bool ok = row < M;
                    float ss = 0.f;
#pragma unroll
                    for (int bj = 0; bj < 2; ++bj)
#pragma unroll
                        for (int n = 0; n < 2; ++n) {
                            const int col = col0 + bj * 128 + n * 16;
                            const f32x4 v = xv[mm][bj][n] + acc[ai][bj][m][n];
                            ss += v[0] * v[0] + v[1] * v[1] + v[2] * v[2] + v[3] * v[3];
                            if (ok) *(f32x4*)(X1 + (size_t)row * D + col) = v;
                            u32x2 w; w.x = cvt_pk_bf16(v[0], v[1]); w.y = cvt_pk_bf16(v[2], v[3]);
                            *(u32x2*)(X1B + (size_t)row * D + col) = w;
                        }
                    ss += __shfl_xor(ss, 16); ss += __shfl_xor(ss, 32);
                    if (fq == 0) atomicAdd(ssq + row, ss);
                }
                asm volatile("" ::: "memory");
            }
    }
};

struct EpiGU {
    static constexpr bool PERM = true, AFTER_DRAIN = false;
    bf16_t* ACT; const float* ssq;
    __device__ __forceinline__ void operator()(AccRef acc, const Unit& u, int wr, int wc, int fr, int fq) const {
        const int row0 = u.pm * 256 + wr * 64 + fr, col = u.pn * 128 + wc * 32 + 8 * fq;
#pragma unroll
        for (int ai = 0; ai < 2; ++ai)
#pragma unroll
            for (int m = 0; m < 4; ++m) {
                const int row = row0 + ai * 128 + m * 16;
                const float rstd = rsqrtf(ssq[row] * (1.f / D) + 1e-6f);
                f32x4 o[2];
#pragma unroll
                for (int n = 0; n < 2; ++n)
#pragma unroll
                    for (int j = 0; j < 4; ++j) { const float g = acc[ai][0][m][n][j] * rstd, uu = acc[ai][1][m][n][j] * rstd; o[n][j] = g * sigmoidf_(g) * uu; }
                *(u32x4*)(ACT + (size_t)row * DFF + col) = pack8(o[0], o[1]);
            }
    }
};

struct EpiDown {
    static constexpr bool PERM = false, AFTER_DRAIN = false;
    float* X;
    __device__ __forceinline__ void operator()(AccRef acc, const Unit& u, int wr, int wc, int fr, int fq) const {
        const int row0 = u.pm * 256 + wr * 64 + fr, col0 = u.pn * 256 + wc * 32 + 4 * fq;
#pragma unroll
        for (int ai = 0; ai < 2; ++ai)
#pragma unroll
            for (int mh = 0; mh < 2; ++mh) {
                f32x4 xv[2][2][2];
#pragma unroll
                for (int mm = 0; mm < 2; ++mm) {
                    const int row = row0 + ai * 128 + (2 * mh + mm) * 16, rc = row < M ? row : M - 1;
#pragma unroll
                    for (int bj = 0; bj < 2; ++bj)
#pragma unroll
                        for (int n = 0; n < 2; ++n) xv[mm][bj][n] = *(const f32x4*)(X + (size_t)rc * D + col0 + bj * 128 + n * 16);
                }
#pragma unroll
                for (int mm = 0; mm < 2; ++mm) {
                    const int m = 2 * mh + mm, row = row0 + ai * 128 + m * 16;
                    if (row < M) {
#pragma unroll
                        for (int bj = 0; bj < 2; ++bj)
#pragma unroll
                            for (int n = 0; n < 2; ++n) *(f32x4*)(X + (size_t)row * D + col0 + bj * 128 + n * 16) = xv[mm][bj][n] + acc[ai][bj][m][n];
                    }
                }
                asm volatile("" ::: "memory");
            }
    }
};


__device__ void phase_lora_inputs(const Params& p) {
    const bf16_t* PR = (const bf16_t*)(p.ws + WS_PR); bf16_t* LIN = (bf16_t*)(p.ws + WS_LIN);
    const float* mu = p.in[7]; const float* shs = p.in[3];
    for (int idx = blockIdx.x * NTHR + tidx(); idx < M * 32; idx += gridDim.x * NTHR) {
        const int row = idx >> 5, gq = idx & 31, col = 1536 + 8 * gq;
        const bool first = row >= TP || (row & (SEQ - 1)) == 0;
        const u32x4 cw = *(const u32x4*)(PR + (size_t)row * RP + col), pw = *(const u32x4*)(PR + (size_t)(row - (first ? 0 : 1)) * RP + col);
        const int sr = row >= TP ? row - TP : 0;
        const f32x4 z0 = *(const f32x4*)(shs + (size_t)sr * RP + col), z1 = *(const f32x4*)(shs + (size_t)sr * RP + col + 4);
        const f32x4 m0 = *(const f32x4*)(mu + col), m1 = *(const f32x4*)(mu + col + 4);
        f32x4 c0, c1, q0, q1; unpack8(cw, c0, c1); unpack8(pw, q0, q1);
        if (first) { if (row >= TP) { q0 = z0; q1 = z1; } else { q0 = (f32x4){0.f, 0.f, 0.f, 0.f}; q1 = q0; } }
        f32x4 s0 = c0 + m0 * (q0 - c0), s1 = c1 + m1 * (q1 - c1);
        if (gq < 8 || gq >= 16) {
            const bool th = gq < 8; const float ksc = th ? 2.f : 1.f, asc = th ? 2.f : 1.f, bsc = th ? -1.f : 0.f;
#pragma unroll
            for (int q = 0; q < 4; ++q) { s0[q] = asc * sigmoidf_(ksc * s0[q]) + bsc; s1[q] = asc * sigmoidf_(ksc * s1[q]) + bsc; }
        }
        *(u32x4*)(LIN + (size_t)row * 256 + 8 * gq) = pack8(s0, s1);
    }
}
struct EpiLora {
    static constexpr bool PERM = true, AFTER_DRAIN = false;
    bf16_t* LD; bf16_t* AA; bf16_t* GG; const float* w0; const float* a0;
    __device__ __forceinline__ void operator()(AccRef acc, const Unit& u, int wr, int wc, int fr, int fq) const {
        const int row0 = u.pm * 256 + wr * 64 + fr, cl = wc * 32 + 8 * fq, ty = u.pn >> 1;
#pragma unroll
        for (int bj = 0; bj < 2; ++bj) {
            const int cc = (u.pn & 1) * 256 + bj * 128 + cl;
            f32x4 b0 = {0.f, 0.f, 0.f, 0.f}, b1 = b0;
            if (ty == 0) { b0 = *(const f32x4*)(w0 + cc); b1 = *(const f32x4*)(w0 + cc + 4); } else if (ty == 1) { b0 = *(const f32x4*)(a0 + cc); b1 = *(const f32x4*)(a0 + cc + 4); }
#pragma unroll
            for (int ai = 0; ai < 2; ++ai)
#pragma unroll
                for (int m = 0; m < 4; ++m) {
                    const int row = row0 + ai * 128 + m * 16;
                    f32x4 v0 = acc[ai][bj][m][0] + b0, v1 = acc[ai][bj][m][1] + b1;
                    if (ty == 0) {
#pragma unroll
                        for (int q = 0; q < 4; ++q) { const float z0 = -v0[q], z1 = -v1[q];
                            v0[q] = -__expf(-(fmaxf(z0, 0.f) + __logf(1.f + __expf(-fabsf(z0)))) - 0.5f); v1[q] = -__expf(-(fmaxf(z1, 0.f) + __logf(1.f + __expf(-fabsf(z1)))) - 0.5f); }
                    } else if (ty == 1) {
#pragma unroll
                        for (int q = 0; q < 4; ++q) { v0[q] = sigmoidf_(v0[q]); v1[q] = sigmoidf_(v1[q]); }
                    }
                    const u32x4 w = pack8(v0, v1);
                    if (ty == 0) *(u32x4*)(LD + (size_t)row * 512 + cc) = w; else if (ty == 1) *(u32x4*)(AA + (size_t)row * 512 + cc) = w; else *(u32x4*)(GG + (size_t)row * 512 + cc) = w;
                }
        }
    }
};

__device__ __forceinline__ f32x4 mfma16(const bf16x8 a, const bf16x8 b, const f32x4 c) { return __builtin_amdgcn_mfma_f32_16x16x32_bf16(a, b, c, 0, 0, 0); }

__device__ void rwkv_seq_item(const Params& p, unsigned char* lds, int row0, int T, int h, const float* __restrict__ S_init, const float* __restrict__ shift_prev, float* __restrict__ S_out, int half) {
#define RW_BAR() do { asm volatile("s_waitcnt lgkmcnt(0)" ::: "memory"); __builtin_amdgcn_s_barrier(); asm volatile("" ::: "memory"); } while (0)
    constexpr int BUFB = 9 * 4096;
    float* sA = (float*)(lds + 73728);
    bf16_t* sTW = (bf16_t*)(lds + 77824); bf16_t* sAD = (bf16_t*)(lds + 80128); bf16_t* sSG = (bf16_t*)(lds + 82432);
    bf16_t* w2t = (bf16_t*)(lds + 86784); bf16_t* a2t = (bf16_t*)(lds + 96000); bf16_t* g2t = (bf16_t*)(lds + 105216);
    float* sMu = (float*)(lds + 122624); float* sCst = (float*)(lds + 124416);
    const int tid = tidx(), lane = tid & 63, wave = __builtin_amdgcn_readfirstlane(tid >> 6);
    const bf16_t* PR = (const bf16_t*)(p.ws + WS_PR);
    bf16_t* OA = (bf16_t*)(p.ws + WS_OA);
    const float *mu = p.in[7], *w0 = p.in[8], *w2 = p.in[9], *a0 = p.in[10], *a2 = p.in[11], *g2 = p.in[12], *k_k = p.in[13], *k_a = p.in[14], *r_k = p.in[15], *ln_g = p.in[16], *ln_b = p.in[17];
    __syncthreads();
    if (tid < 448) { const int j = tid; sMu[j] = mu[j < 64 ? 64 * h + j : (j < 128 ? 512 + 64 * h + (j - 64) : (j < 192 ? 1024 + 64 * h + (j - 128) : 1536 + (j - 192)))]; }
    else if (tid < 512) { const int c = tid - 448, cg = 64 * h + c; sCst[c] = k_k[cg]; sCst[64 + c] = k_a[cg]; sCst[128 + c] = r_k[cg]; sCst[192 + c] = ln_g[cg]; sCst[256 + c] = ln_b[cg]; sCst[320 + c] = w0[cg]; sCst[384 + c] = a0[cg]; }
    __syncthreads();
    const int NC = (T + 15) >> 4;
    if (wave < 4) {
        __builtin_amdgcn_s_setprio(2);
        const bool full = half < 0;
        const int rA = full ? 16 * wave + 2 * (lane >> 3) : 32 * half + 8 * wave + (lane >> 3), rB = full ? rA + 1 : rA, kp = lane & 7, lo = kp * 8;
        f2 SA[4], SB[4];
        if (S_init) {
            const f32x4 a0_ = *(const f32x4*)(S_init + rA * 64 + lo), a1_ = *(const f32x4*)(S_init + rA * 64 + lo + 4), b0_ = *(const f32x4*)(S_init + rB * 64 + lo), b1_ = *(const f32x4*)(S_init + rB * 64 + lo + 4);
            SA[0] = (f2){a0_[0], a0_[1]}; SA[1] = (f2){a0_[2], a0_[3]}; SA[2] = (f2){a1_[0], a1_[1]}; SA[3] = (f2){a1_[2], a1_[3]};
            SB[0] = (f2){b0_[0], b0_[1]}; SB[1] = (f2){b0_[2], b0_[3]}; SB[2] = (f2){b1_[0], b1_[1]}; SB[3] = (f2){b1_[2], b1_[3]};
        } else {
#pragma unroll
            for (int j = 0; j < 4; ++j) { SA[j] = (f2){0.f, 0.f}; SB[j] = (f2){0.f, 0.f}; }
        }
#define RW_LD(P, tt) P##d0 = *(const f32x4*)(bR + 3 * 1024 + (tt) * 64 + lo); P##d1 = *(const f32x4*)(bR + 3 * 1024 + (tt) * 64 + lo + 4); P##k0 = *(const f32x4*)(bR + 4 * 1024 + (tt) * 64 + lo); P##k1 = *(const f32x4*)(bR + 4 * 1024 + (tt) * 64 + lo + 4); \
        P##b0 = *(const f32x4*)(bR + 5 * 1024 + (tt) * 64 + lo); P##b1 = *(const f32x4*)(bR + 5 * 1024 + (tt) * 64 + lo + 4); P##q0 = *(const f32x4*)(bR + 1024 + (tt) * 64 + lo); P##q1 = *(const f32x4*)(bR + 1024 + (tt) * 64 + lo + 4); \
        P##r0 = *(const f32x4*)(bR + (tt) * 64 + lo); P##r1 = *(const f32x4*)(bR + (tt) * 64 + lo + 4); P##vv[0] = bR[2 * 1024 + (tt) * 64 + rA]; P##vv[1] = bR[2 * 1024 + (tt) * 64 + rB];
#define RW_ROW(S_, P, vsc, yout) {   \
        const f2 vvv = {vsc, vsc}; \
        const f2 t0_ = S_[0] * (f2){P##d0[0], P##d0[1]} + vvv * (f2){P##q0[0], P##q0[1]}, t1_ = S_[1] * (f2){P##d0[2], P##d0[3]} + vvv * (f2){P##q0[2], P##q0[3]}; \
        const f2 t2_ = S_[2] * (f2){P##d1[0], P##d1[1]} + vvv * (f2){P##q1[0], P##q1[1]}, t3_ = S_[3] * (f2){P##d1[2], P##d1[3]} + vvv * (f2){P##q1[2], P##q1[3]}; \
        const f2 sa2 = (S_[0] * (f2){P##k0[0], P##k0[1]} + S_[1] * (f2){P##k0[2], P##k0[3]}) + (S_[2] * (f2){P##k1[0], P##k1[1]} + S_[3] * (f2){P##k1[2], P##k1[3]}); \
        const float sa = -red8(sa2[0] + sa2[1]); const f2 sav = {sa, sa}; \
        S_[0] = t0_ + sav * (f2){P##b0[0], P##b0[1]}; S_[1] = t1_ + sav * (f2){P##b0[2], P##b0[3]}; S_[2] = t2_ + sav * (f2){P##b1[0], P##b1[1]}; S_[3] = t3_ + sav * (f2){P##b1[2], P##b1[3]}; \
        const f2 y2 = (S_[0] * (f2){P##r0[0], P##r0[1]} + S_[1] * (f2){P##r0[2], P##r0[3]}) + (S_[2] * (f2){P##r1[0], P##r1[1]} + S_[3] * (f2){P##r1[2], P##r1[3]}); \
        yout = red8(y2[0] + y2[1]); }
#define RW_STEP(P, tt) { float yA_, yB_; RW_ROW(SA, P, P##vv[0], yA_) ((float*)bR)[8 * 1024 + (tt) * 64 + rA] = yA_; if (full) { RW_ROW(SB, P, P##vv[1], yB_) ((float*)bR)[8 * 1024 + (tt) * 64 + rB] = yB_; } }
#define RW_PAIR(t) { RW_LD(B, (t) + 1) RW_STEP(A, (t)) RW_LD(A, ((t) + 2) & 15) RW_STEP(B, (t) + 1) }
        f32x4 Ad0, Ad1, Ak0, Ak1, Ab0, Ab1, Aq0, Aq1, Ar0, Ar1, Bd0, Bd1, Bk0, Bk1, Bb0, Bb1, Bq0, Bq1, Br0, Br1; f2 Avv, Bvv;
        for (int c = 0; c <= NC + 1; ++c) {
            if (c >= 1 && c <= NC) {
                const int cc = c - 1, nt = (T - 16 * cc) < 16 ? (T - 16 * cc) : 16;
                const float* bR = (const float*)(lds + (cc & 1) * BUFB);
                if (nt == 16) {
                    RW_LD(A, 0)
                    RW_PAIR(0) RW_PAIR(2) RW_PAIR(4) RW_PAIR(6)
                    RW_BAR();
                    RW_PAIR(8) RW_PAIR(10) RW_PAIR(12) RW_PAIR(14)
                    RW_BAR();
                } else {
                    for (int t = 0; t < nt; ++t) { RW_LD(A, t) RW_STEP(A, t) }
                    RW_BAR(); RW_BAR();
                }
            } else { RW_BAR(); RW_BAR(); }
        }
#undef RW_LD
#undef RW_ROW
#undef RW_STEP
#undef RW_PAIR
        __builtin_amdgcn_s_setprio(0);
        float* so = S_out + rA * 64 + lo;
        *(f32x4*)so = (f32x4){SA[0][0], SA[0][1], SA[1][0], SA[1][1]}; *(f32x4*)(so + 4) = (f32x4){SA[2][0], SA[2][1], SA[3][0], SA[3][1]};
        if (full) { *(f32x4*)(so + 64) = (f32x4){SB[0][0], SB[0][1], SB[1][0], SB[1][1]}; *(f32x4*)(so + 68) = (f32x4){SB[2][0], SB[2][1], SB[3][0], SB[3][1]}; }
    } else {
        const int ptid = tid - 256, pw = wave - 4;
        float* sBon = (float*)(lds + 126208);
        bf16_t* Yg = (bf16_t*)(p.ws + WS_OA); float* BONg = (float*)(p.ws + WS_BON);
        u32x4 pfc[2], pfp[2], pfl[2], pfcB[2], pfpB[2], pflB[2];
        const bf16_t* LDg = (const bf16_t*)(p.ws + WS_LD); const bf16_t* AAg = (const bf16_t*)(p.ws + WS_AA); const bf16_t* GGg = (const bf16_t*)(p.ws + WS_GG);
#define RW_COL(gi_) ((gi_) < 8 ? 64 * h + 8 * (gi_) : ((gi_) < 16 ? 512 + 64 * h + 8 * ((gi_) - 8) : ((gi_) < 24 ? 1024 + 64 * h + 8 * ((gi_) - 16) : 1536 + 8 * ((gi_) - 24))))
#define RW_GI(i_, j_) ((i_) == 0 ? (j_) : ((i_) == 1 ? ((j_) < 8 ? 16 + (j_) : 24 + (j_)) : ((i_) == 2 ? ((j_) < 8 ? 24 + (j_) : 32 + (j_)) : 48 + ((j_) & 7))))
#define RW_PREFETCH(cn) do { const int tb_ = 16 * (cn); const int ntn_ = (T - tb_) < 16 ? (T - tb_) : 16; const int t_ = (ptid >> 4) < ntn_ ? (ptid >> 4) : ntn_ - 1;   \
        const size_t row_ = (size_t)row0 + tb_ + t_; const size_t rowp_ = row_ - (tb_ + t_ > 0 ? 1 : 0); \
        _Pragma("unroll") for (int i_ = 0; i_ < 2; ++i_) { const int gi_ = (ptid & 15) + 8 * i_ * (1 + (((ptid & 15) < 8) ? 1 : 0));   \
            const int col_ = RW_COL(gi_); pfc[i_] = *(const u32x4*)(PR + row_ * RP + col_); pfp[i_] = *(const u32x4*)(PR + rowp_ * RP + col_); } \
        } while (0)
#define RW_PREFETCH_L(cn) do { const int tb_ = 16 * (cn); const int ntn_ = (T - tb_) < 16 ? (T - tb_) : 16; const int t2_ = ((ptid >> 3) & 15) < ntn_ ? ((ptid >> 3) & 15) : ntn_ - 1; \
        const size_t o_ = ((size_t)row0 + tb_ + t2_) * 512 + 64 * h + 8 * (ptid & 7); pfl[0] = *(const u32x4*)(((ptid >> 7) ? AAg : LDg) + o_); pfl[1] = *(const u32x4*)(GGg + o_); } while (0)
        RW_PREFETCH(0); RW_PREFETCH_L(0);
        if (NC > 1) { auto pf1 = [&](u32x4 (&pfc)[2], u32x4 (&pfp)[2], u32x4 (&pfl)[2]) __attribute__((always_inline)) { RW_PREFETCH(1); RW_PREFETCH_L(1); }; pf1(pfcB, pfpB, pflB); }
        auto prep_iter = [&](const int c, u32x4 (&pfc)[2], u32x4 (&pfp)[2], u32x4 (&pfl)[2]) __attribute__((always_inline)) {
            if (c >= 2) {
                const int cc = c - 2, nt = (T - 16 * cc) < 16 ? (T - 16 * cc) : 16;
                const float* bR = (const float*)(lds + (cc & 1) * BUFB);
                if (half >= 0) {
                    if (ptid < 8 * nt) {
                        const int t = ptid >> 3, c8 = 8 * (ptid & 7); const size_t grow = (size_t)row0 + 16 * cc + t;
                        if (((ptid & 7) >> 2) == half) *(u32x4*)(Yg + grow * 512 + 64 * h + c8) = pack8(*(const f32x4*)(bR + 8 * 1024 + t * 64 + c8), *(const f32x4*)(bR + 8 * 1024 + t * 64 + c8 + 4));
                        if (half == 0 && (ptid & 7) == 0) BONg[grow * 8 + h] = sBon[(cc & 1) * 16 + t];
                    }
                } else
                if (ptid < 8 * nt) {
                    const int t = ptid >> 3, c8 = 8 * (ptid & 7);
                    const f32x4 y0 = *(const f32x4*)(bR + 8 * 1024 + t * 64 + c8), y1 = *(const f32x4*)(bR + 8 * 1024 + t * 64 + c8 + 4);
                    const float mean = red8((y0[0] + y0[1]) + (y0[2] + y0[3]) + (y1[0] + y1[1]) + (y1[2] + y1[3])) * (1.f / 64.f);
                    const f32x4 d0 = y0 - mean, d1 = y1 - mean, dq = d0 * d0 + d1 * d1;
                    const float var = red8((dq[0] + dq[1]) + (dq[2] + dq[3])) * (1.f / 64.f);
                    const float rs = rsqrtf(var + 64e-5f);
                    const f32x4 lg0 = *(const f32x4*)(sCst + 192 + c8), lg1 = *(const f32x4*)(sCst + 192 + c8 + 4), lb0 = *(const f32x4*)(sCst + 256 + c8), lb1 = *(const f32x4*)(sCst + 256 + c8 + 4);
                    const f32x4 bv0 = *(const f32x4*)(bR + 7 * 1024 + t * 64 + c8), bv1 = *(const f32x4*)(bR + 7 * 1024 + t * 64 + c8 + 4), g0 = *(const f32x4*)(bR + 6 * 1024 + t * 64 + c8), g1 = *(const f32x4*)(bR + 6 * 1024 + t * 64 + c8 + 4);
                    const f32x4 o0 = (d0 * rs * lg0 + lb0 + bv0) * g0, o1 = (d1 * rs * lg1 + lb1 + bv1) * g1;
                    *(u32x4*)(OA + ((size_t)row0 + 16 * cc + t) * 512 + 64 * h + c8) = pack8(o0, o1);
                }
            }
            const bool act = c < NC;
            const int nt = act ? ((T - 16 * c) < 16 ? (T - 16 * c) : 16) : 0;
            float* bW = (float*)(lds + (c & 1) * BUFB);
            if (act) {
                {
                    const int t = ptid >> 4, j = ptid & 15;
                    if (t < nt) {
#pragma unroll
                        for (int i1 = 0; i1 < 2; ++i1) {
                            if (i1 == 0 || j < 8) {
                                const int gi = j + 16 * i1;
                                f32x4 c0, c1, p0, p1;
                                unpack8(pfc[i1], c0, c1);
                                if (16 * c + t == 0) { if (shift_prev) { const int col = RW_COL(gi); p0 = *(const f32x4*)(shift_prev + col); p1 = *(const f32x4*)(shift_prev + col + 4); } else { p0 = (f32x4){0.f, 0.f, 0.f, 0.f}; p1 = p0; } }
                                else unpack8(pfp[i1], p0, p1);
                                const f32x4 m0 = *(const f32x4*)(sMu + 8 * gi), m1 = *(const f32x4*)(sMu + 8 * gi + 4);
                                const f32x4 s0 = c0 + m0 * (p0 - c0), s1 = c1 + m1 * (p1 - c1);
                                float* d = bW + (gi >> 3) * 1024 + t * 64 + 8 * (gi & 7); *(f32x4*)d = s0; *(f32x4*)(d + 4) = s1;
                            }
                        }
                    }
                }
                if (c + 2 < NC) RW_PREFETCH(c + 2);
                    const int t2 = (ptid >> 3) & 15, c8 = 8 * (ptid & 7);
                    if (t2 < nt) {
                        f32x4 x0, x1; unpack8(pfl[0], x0, x1);
                        if (ptid >> 7) { *(f32x4*)(sA + t2 * 64 + c8) = x0; *(f32x4*)(sA + t2 * 64 + c8 + 4) = x1; }
                        else {
#pragma unroll
                            for (int q = 0; q < 4; ++q) { x0[q] = __expf(x0[q]); x1[q] = __expf(x1[q]); }
                            *(f32x4*)(bW + 3 * 1024 + t2 * 64 + c8) = x0; *(f32x4*)(bW + 3 * 1024 + t2 * 64 + c8 + 4) = x1;
                            f32x4 g0, g1; unpack8(pfl[1], g0, g1);
                            *(f32x4*)(bW + 6 * 1024 + t2 * 64 + c8) = g0; *(f32x4*)(bW + 6 * 1024 + t2 * 64 + c8 + 4) = g1;
                        }
                    }
                if (c + 2 < NC) RW_PREFETCH_L(c + 2);
            }
            RW_BAR();
            if (act && ptid < 8 * nt) {
                const int t = ptid >> 3, c8 = 8 * (ptid & 7);
                f32x4 k0 = *(const f32x4*)(bW + 1024 + t * 64 + c8), k1 = *(const f32x4*)(bW + 1024 + t * 64 + c8 + 4);
                const f32x4 a0v = *(const f32x4*)(sA + t * 64 + c8), a1v = *(const f32x4*)(sA + t * 64 + c8 + 4);
                const f32x4 r0 = *(const f32x4*)(bW + t * 64 + c8), r1 = *(const f32x4*)(bW + t * 64 + c8 + 4);
                const f32x4 v0 = *(const f32x4*)(bW + 2 * 1024 + t * 64 + c8), v1 = *(const f32x4*)(bW + 2 * 1024 + t * 64 + c8 + 4);
                const f32x4 kk0 = *(const f32x4*)(sCst + c8), kk1 = *(const f32x4*)(sCst + c8 + 4), ka0 = *(const f32x4*)(sCst + 64 + c8), ka1 = *(const f32x4*)(sCst + 64 + c8 + 4);
                const f32x4 rk0 = *(const f32x4*)(sCst + 128 + c8), rk1 = *(const f32x4*)(sCst + 128 + c8 + 4);
                f32x4 n0 = k0 * kk0, n1 = k1 * kk1;
                const f32x4 sq = n0 * n0 + n1 * n1;
                const float n2 = red8((sq[0] + sq[1]) + (sq[2] + sq[3]));
                const float inv = __builtin_amdgcn_rcpf(fmaxf(sqrtf(n2), 1e-12f));
                n0 *= inv; n1 *= inv;
                k0 = k0 * (1.f + (a0v - 1.f) * ka0); k1 = k1 * (1.f + (a1v - 1.f) * ka1);
                const f32x4 bs = r0 * k0 * rk0 + r1 * k1 * rk1;
                const float bon = red8((bs[0] + bs[1]) + (bs[2] + bs[3]));
                *(f32x4*)(bW + 1024 + t * 64 + c8) = k0; *(f32x4*)(bW + 1024 + t * 64 + c8 + 4) = k1;
                *(f32x4*)(bW + 4 * 1024 + t * 64 + c8) = n0; *(f32x4*)(bW + 4 * 1024 + t * 64 + c8 + 4) = n1;
                *(f32x4*)(bW + 5 * 1024 + t * 64 + c8) = n0 * a0v; *(f32x4*)(bW + 5 * 1024 + t * 64 + c8 + 4) = n1 * a1v;
                *(f32x4*)(bW + 7 * 1024 + t * 64 + c8) = v0 * bon; *(f32x4*)(bW + 7 * 1024 + t * 64 + c8 + 4) = v1 * bon;
                if ((ptid & 7) == 0) sBon[(c & 1) * 16 + t] = bon;
            }
            RW_BAR();
                };
        for (int c = 0; c <= NC + 1; c += 2) { prep_iter(c, pfc, pfp, pfl); if (c + 1 <= NC + 1) prep_iter(c + 1, pfcB, pfpB, pflB); }
        __builtin_amdgcn_s_setprio(0);
#undef RW_PREFETCH
#undef RW_PREFETCH_L
#undef RW_COL
#undef RW_GI
#undef RW_BAR
    }
    __syncthreads();
}

__device__ void hgrn_seq_item(const Params& p, unsigned char* lds, int row0, int T, int h, const float* __restrict__ S_init, float* __restrict__ S_out) {
    float* sF = (float*)lds; float* sQ = sF + 4096; float* sI = sQ + 4096; float* sO = sI + 4096;
    const int tid = tidx(), lane = tid & 63, wave = tid >> 6, col = tid >> 2, kp = tid & 3;
    const float* F = (const float*)(p.ws + WS_F); const bf16_t* QS = (const bf16_t*)(p.ws + WS_QS); const bf16_t* HI = (const bf16_t*)(p.ws + WS_HI);
    const bf16_t* OG = (const bf16_t*)(p.ws + WS_OG); bf16_t* OB = (bf16_t*)(p.ws + WS_OB); const float* norm_g = p.in[20];
    float S[32];
#pragma unroll
    for (int j = 0; j < 32; ++j) S[j] = S_init ? S_init[(32 * kp + j) * 128 + col] : 0.f;
    __syncthreads();
    for (int t0 = 0; t0 < T; t0 += 32) {
        const int nt = (T - t0) < 32 ? (T - t0) : 32;
        for (int idx = tid; idx < nt * 128; idx += NTHR) { const int t = idx >> 7, c = idx & 127; const size_t o = ((size_t)row0 + t0 + t) * 512 + 128 * h + c;
            sF[idx] = F[o]; sQ[idx] = bf2f(QS[o]); sI[idx] = bf2f(HI[o]); }
        __syncthreads();
        for (int t = 0; t < nt; ++t) {
            const float iv = sI[t * 128 + col]; float o = 0.f;
#pragma unroll
            for (int j4 = 0; j4 < 8; ++j4) {
                const float4 f = *(const float4*)(sF + t * 128 + 32 * kp + 4 * j4), q = *(const float4*)(sQ + t * 128 + 32 * kp + 4 * j4);
                S[4 * j4 + 0] = f.x * S[4 * j4 + 0] + (1.f - f.x) * iv; o += q.x * S[4 * j4 + 0];
                S[4 * j4 + 1] = f.y * S[4 * j4 + 1] + (1.f - f.y) * iv; o += q.y * S[4 * j4 + 1];
                S[4 * j4 + 2] = f.z * S[4 * j4 + 2] + (1.f - f.z) * iv; o += q.z * S[4 * j4 + 2];
                S[4 * j4 + 3] = f.w * S[4 * j4 + 3] + (1.f - f.w) * iv; o += q.w * S[4 * j4 + 3];
            }
            o += dppf<0xB1>(o); o += dppf<0x4E>(o);
            if (kp == 0) sO[t * 128 + col] = o;
        }
        __syncthreads();
        for (int t = wave; t < nt; t += 8) {
            const float o1 = sO[t * 128 + lane], o2 = sO[t * 128 + 64 + lane];
            const float ss = wave_sum(o1 * o1 + o2 * o2);
            const float rstd = rsqrtf(ss * (1.f / 128.f) + 1e-6f);
            const size_t o = ((size_t)row0 + t0 + t) * 512 + 128 * h + lane;
            OB[o] = f2bf(o1 * rstd * norm_g[128 * h + lane] * bf2f(OG[o]));
            OB[o + 64] = f2bf(o2 * rstd * norm_g[128 * h + 64 + lane] * bf2f(OG[o + 64]));
        }
        __syncthreads();
    }
#pragma unroll
    for (int j = 0; j < 32; ++j) S_out[(32 * kp + j) * 128 + col] = S[j];
}

constexpr int HQ_OFF = 0, HK_OFF = 17408, HKH_OFF = 34816, HVT_OFF = 53248, HP_OFF = 71680, HS_OFF = 80896, HD_OFF = 115712, HSEG_OFF = 116224, HSS_OFF = 118272;
__device__ void hgrn_chunk_item(const Params& p, unsigned char* lds, int b, int h) {
    bf16_t* Qt = (bf16_t*)(lds + HQ_OFF);
    bf16_t* Kt = (bf16_t*)(lds + HK_OFF);
    bf16_t* KhT = (bf16_t*)(lds + HKH_OFF);
    bf16_t* VT = (bf16_t*)(lds + HVT_OFF);
    bf16_t* Pm = (bf16_t*)(lds + HP_OFF);
    bf16_t* S0T = (bf16_t*)(lds + HS_OFF);
    float* dk = (float*)(lds + HD_OFF);
    float* segt = (float*)(lds + HSEG_OFF);
    float* ssp = (float*)(lds + HSS_OFF);
    const int tid = tidx(), lane = tid & 63, wave = tid >> 6, li = lane & 15, lq = lane >> 4;
    const float* F = (const float*)(p.ws + WS_F); const bf16_t* QS = (const bf16_t*)(p.ws + WS_QS); const bf16_t* HI = (const bf16_t*)(p.ws + WS_HI);
    const bf16_t* OG = (const bf16_t*)(p.ws + WS_OG); bf16_t* OB = (bf16_t*)(p.ws + WS_OB); const float* norm_g = p.in[20];
    f32x4 Sacc[8];
#pragma unroll
    for (int i = 0; i < 8; ++i) Sacc[i] = (f32x4){0.f, 0.f, 0.f, 0.f};
    __syncthreads();
    for (int i = tid; i < 128 * 136 / 2; i += NTHR) ((unsigned*)S0T)[i] = 0u;
    const int kch = tid & 127, seg = tid >> 7;
    for (int c0 = 0; c0 < SEQ; c0 += 64) {
        const size_t rbase = (size_t)b * SEQ + c0;
        {
            float fv[16], cb[16]; float run = 0.f;
#pragma unroll
            for (int j = 0; j < 16; ++j) { fv[j] = F[(rbase + 16 * seg + j) * 512 + 128 * h + kch]; run += __logf(fv[j]); cb[j] = run; }
            segt[seg * 128 + kch] = run;
            __syncthreads();
            float off = 0.f, tot = 0.f;
#pragma unroll
            for (int s = 0; s < 4; ++s) { const float v = segt[s * 128 + kch]; tot += v; if (s < seg) off += v; }
            const float etot = __expf(tot);
            if (seg == 0) dk[kch] = etot;
            unsigned kh[8];
#pragma unroll
            for (int j = 0; j < 16; j += 2) {
                float kk2[2];
#pragma unroll
                for (int e = 0; e < 2; ++e) {
                    const float bb = off + cb[j + e], eb = __expf(bb), ieb = __builtin_amdgcn_rcpf(eb), kf = 1.f - fv[j + e];
                    const float q = bf2f(QS[(rbase + 16 * seg + j + e) * 512 + 128 * h + kch]);
                    Qt[(16 * seg + j + e) * 136 + kch] = f2bf(q * eb);
                    Kt[(16 * seg + j + e) * 136 + kch] = f2bf(kf * ieb);
                    kk2[e] = kf * ieb * etot;
                }
                kh[j >> 1] = cvt_pk_bf16(kk2[0], kk2[1]);
            }
            *(u32x4*)(KhT + kch * 72 + 16 * seg) = (u32x4){kh[0], kh[1], kh[2], kh[3]};
            *(u32x4*)(KhT + kch * 72 + 16 * seg + 8) = (u32x4){kh[4], kh[5], kh[6], kh[7]};
            unsigned vv[8];
#pragma unroll
            for (int j = 0; j < 16; j += 2) {
                const unsigned lo = HI[(rbase + 16 * seg + j) * 512 + 128 * h + kch], hi = HI[(rbase + 16 * seg + j + 1) * 512 + 128 * h + kch];
                vv[j >> 1] = lo | (hi << 16);
            }
            *(u32x4*)(VT + kch * 72 + 16 * seg) = (u32x4){vv[0], vv[1], vv[2], vv[3]};
            *(u32x4*)(VT + kch * 72 + 16 * seg + 8) = (u32x4){vv[4], vv[5], vv[6], vv[7]};
        }
        __syncthreads();
        {
            const int ti = wave >> 1;
#pragma unroll
            for (int u = 0; u < 2; ++u) {
                const int si = 2 * (wave & 1) + u;
                f32x4 acc = {0.f, 0.f, 0.f, 0.f};
                if (si <= ti) {
#pragma unroll
                    for (int ks = 0; ks < 4; ++ks)
                        acc = mfma16(*(const bf16x8*)(Kt + (16 * si + li) * 136 + 8 * lq + 32 * ks), *(const bf16x8*)(Qt + (16 * ti + li) * 136 + 8 * lq + 32 * ks), acc);
                }
                const int t = 16 * ti + li, s0 = 16 * si + 4 * lq;
                u32x2 w; w.x = cvt_pk_bf16(s0 + 0 <= t ? acc[0] : 0.f, s0 + 1 <= t ? acc[1] : 0.f); w.y = cvt_pk_bf16(s0 + 2 <= t ? acc[2] : 0.f, s0 + 3 <= t ? acc[3] : 0.f);
                *(u32x2*)(Pm + t * 72 + s0) = w;
            }
        }
        __syncthreads();
        {
            const int ti = wave & 3, vh = wave >> 2, t = 16 * ti + li;
            bf16x8 bq[4], bp[2];
#pragma unroll
            for (int ks = 0; ks < 4; ++ks) bq[ks] = *(const bf16x8*)(Qt + t * 136 + 8 * lq + 32 * ks);
#pragma unroll
            for (int ks = 0; ks < 2; ++ks) bp[ks] = *(const bf16x8*)(Pm + t * 72 + 8 * lq + 32 * ks);
            f32x4 o[4]; float ss = 0.f;
#pragma unroll
            for (int vt = 0; vt < 4; ++vt) {
                const int vr = 64 * vh + 16 * vt + li;
                f32x4 acc = {0.f, 0.f, 0.f, 0.f};
#pragma unroll
                for (int ks = 0; ks < 4; ++ks) acc = mfma16(*(const bf16x8*)(S0T + vr * 136 + 8 * lq + 32 * ks), bq[ks], acc);
#pragma unroll
                for (int ks = 0; ks < 2; ++ks) acc = mfma16(*(const bf16x8*)(VT + vr * 72 + 8 * lq + 32 * ks), bp[ks], acc);
                o[vt] = acc; ss += acc[0] * acc[0] + acc[1] * acc[1] + acc[2] * acc[2] + acc[3] * acc[3];
            }
            ss += __shfl_xor(ss, 16); ss += __shfl_xor(ss, 32);
            if (lq == 0) ssp[vh * 64 + t] = ss;
            __syncthreads();
            const float rstd = rsqrtf((ssp[t] + ssp[64 + t]) * (1.f / 128.f) + 1e-6f);
            const size_t orow = (rbase + t) * 512 + 128 * h;
#pragma unroll
            for (int vt = 0; vt < 4; ++vt) {
                const int v = 64 * vh + 16 * vt + 4 * lq;
                const f32x4 g = *(const f32x4*)(norm_g + 128 * h + v);
                const u32x2 og = *(const u32x2*)(OG + orow + v);
                u32x2 w;
                w.x = cvt_pk_bf16(o[vt][0] * rstd * g[0] * __uint_as_float(og.x << 16), o[vt][1] * rstd * g[1] * __uint_as_float(og.x & 0xffff0000u));
                w.y = cvt_pk_bf16(o[vt][2] * rstd * g[2] * __uint_as_float(og.y << 16), o[vt][3] * rstd * g[3] * __uint_as_float(og.y & 0xffff0000u));
                *(u32x2*)(OB + orow + v) = w;
            }
        }
        {
            const f32x4 dv = *(const f32x4*)(dk + 16 * wave + 4 * lq);
            bf16x8 ak[2];
#pragma unroll
            for (int ks = 0; ks < 2; ++ks) ak[ks] = *(const bf16x8*)(KhT + (16 * wave + li) * 72 + 8 * lq + 32 * ks);
#pragma unroll
            for (int vt = 0; vt < 8; ++vt) {
                f32x4 acc = Sacc[vt] * dv;
#pragma unroll
                for (int ks = 0; ks < 2; ++ks) acc = mfma16(ak[ks], *(const bf16x8*)(VT + (16 * vt + li) * 72 + 8 * lq + 32 * ks), acc);
                Sacc[vt] = acc;
                u32x2 w; w.x = cvt_pk_bf16(acc[0], acc[1]); w.y = cvt_pk_bf16(acc[2], acc[3]);
                *(u32x2*)(S0T + (16 * vt + li) * 136 + 16 * wave + 4 * lq) = w;
            }
        }
        __syncthreads();
    }
    float* so = p.out + O_HGP + (size_t)(b * 4 + h) * 16384;
#pragma unroll
    for (int vt = 0; vt < 8; ++vt)
#pragma unroll
        for (int j = 0; j < 4; ++j) so[(16 * wave + 4 * lq + j) * 128 + 16 * vt + li] = Sacc[vt][j];
}


struct Order2 {
    pg8::StaticOrder st; int sub, n, G, c;
    __device__ __forceinline__ void init(int pass, int N, int Gg, int cc) { sub = pass == 0; n = N / 256; G = Gg - 160; c = cc - 160; st.init(TP, N, Gg, cc); }
    __device__ __forceinline__ bool next(int i, Unit& u) const { if (sub) { const int L = i * G + c; if (L >= n) return false; u.pm = 64; u.pn = L; return true; } return st.next(i, u); }
    __device__ __forceinline__ void a_ready(const Unit&) const {}
    __device__ __forceinline__ void done(const Unit&) const {}
};
struct EpiMerge2 {
    static constexpr bool PERM = true, AFTER_DRAIN = false;
    bf16_t* MG; const bf16_t* GATE;
    __device__ __forceinline__ void operator()(AccRef acc, const Unit& u, int wr, int wc, int fr, int fq) const {
        if (u.pm >= 65) { const Unit v{u.pm - 65, u.pn - 4}; const EpiMerge<true> e{MG, GATE}; e(acc, v, wr, wc, fr, fq); }
        else { const EpiMerge<false> e{MG, GATE}; e(acc, u, wr, wc, fr, fq); }
    }
};
struct OrderMerge {
    Order2 o;
    __device__ __forceinline__ bool next(int i, Unit& u) const { if (!o.next(i >> 1, u)) return false; if (i & 1) { u.pm += 65; u.pn += 4; } return true; }
    __device__ __forceinline__ void a_ready(const Unit&) const {}
    __device__ __forceinline__ void done(const Unit&) const {}
};

__device__ __forceinline__ void sub_barrier(unsigned* ctr, unsigned target) {
    __syncthreads();
    if (tidx() == 0) {
        __threadfence();
        __hip_atomic_fetch_add(ctr, 1u, __ATOMIC_RELEASE, __HIP_MEMORY_SCOPE_AGENT);
        while (__hip_atomic_load(ctr, __ATOMIC_ACQUIRE, __HIP_MEMORY_SCOPE_AGENT) < target) __builtin_amdgcn_s_sleep(4);
        __threadfence();
    }
    __syncthreads();
}

__device__ void rwkv_post_pass(const Params& p) {
    const bf16_t* Gg = (const bf16_t*)(p.ws + WS_GG); const float* BONg = (const float*)(p.ws + WS_BON);
    const bf16_t* PR = (const bf16_t*)(p.ws + WS_PR); bf16_t* OA = (bf16_t*)(p.ws + WS_OA);
    const float *mu = p.in[7], *ln_g = p.in[16], *ln_b = p.in[17];
    for (int idx = blockIdx.x * NTHR + tidx(); idx < TP * 64; idx += gridDim.x * NTHR) {
        const int item = idx >> 3, row = item >> 3, h = item & 7, cg = 64 * h + 8 * (idx & 7);
        const u32x4 yw = *(const u32x4*)(OA + (size_t)row * 512 + cg), gw = *(const u32x4*)(Gg + (size_t)row * 512 + cg);
        const bool first = (row & (SEQ - 1)) == 0;
        const u32x4 pcw = *(const u32x4*)(PR + (size_t)row * RP + 1024 + cg), ppw = *(const u32x4*)(PR + (size_t)(row - (first ? 0 : 1)) * RP + 1024 + cg);
        const f32x4 m0 = *(const f32x4*)(mu + 1024 + cg), m1 = *(const f32x4*)(mu + 1024 + cg + 4);
        const f32x4 lg0 = *(const f32x4*)(ln_g + cg), lg1 = *(const f32x4*)(ln_g + cg + 4), lb0 = *(const f32x4*)(ln_b + cg), lb1 = *(const f32x4*)(ln_b + cg + 4);
        const float bon = BONg[(size_t)row * 8 + h];
        f32x4 y0, y1, c0, c1, q0, q1, g0, g1; unpack8(yw, y0, y1); unpack8(pcw, c0, c1); unpack8(ppw, q0, q1); unpack8(gw, g0, g1);
        if (first) { q0 = (f32x4){0.f, 0.f, 0.f, 0.f}; q1 = q0; }
        const f32x4 v0 = c0 + m0 * (q0 - c0), v1 = c1 + m1 * (q1 - c1);
        const float mean = red8((y0[0] + y0[1]) + (y0[2] + y0[3]) + (y1[0] + y1[1]) + (y1[2] + y1[3])) * (1.f / 64.f);
        const f32x4 d0 = y0 - mean, d1 = y1 - mean, dq = d0 * d0 + d1 * d1;
        const float var = red8((dq[0] + dq[1]) + (dq[2] + dq[3])) * (1.f / 64.f);
        const float rs = rsqrtf(var + 64e-5f);
        const f32x4 o0 = (d0 * rs * lg0 + lb0 + bon * v0) * g0, o1 = (d1 * rs * lg1 + lb1 + bon * v1) * g1;
        *(u32x4*)(OA + (size_t)row * 512 + cg) = pack8(o0, o1);
    }
}

__device__ void phase_mix_seq(const Params& p, unsigned char* lds) {
    const int blk = blockIdx.x;
    float* out = p.out;
    if (blk >= 128 && blk < 160) { const int i = blk - 128, b = i >> 2, h = i & 3; hgrn_chunk_item(p, lds, b, h); return; }
    unsigned* arrive = (unsigned*)(p.ws + WS_SUBBAR);
    const bool pr = blk < 128;
    int it = pr ? 128 + blk : 128 + 256 + (blk - 160);
    const int end = pr ? 128 + 256 : 128 + 1536, step = pr ? 128 : (int)gridDim.x - 160;
    bool prompt_pending = pr;
#pragma nounroll
    for (;;) {
        int cur;
        if (it < end) { cur = it; it += step; }
        else if (prompt_pending) {
            __syncthreads();
            if (tidx() == 0) { __threadfence(); __hip_atomic_fetch_add(arrive, 1u, __ATOMIC_RELEASE, __HIP_MEMORY_SCOPE_AGENT); }
            cur = blk; prompt_pending = false;
        } else break;
        if (cur < 128 + 1024) {
            int row0, T, half; const float* si; const float* sp; float* so; int h;
            if (cur < 128) { const int bh = cur >> 1, b = bh >> 3; h = bh & 7; half = cur & 1; row0 = b * SEQ; T = SEQ; si = nullptr; sp = nullptr; so = out + O_WKVP + (size_t)(b * 8 + h) * 4096; }
            else { const int j = cur - 128, b = j >> 3; h = j & 7; half = -1; row0 = TP + b; T = 1; si = p.in[2] + (size_t)(b * 8 + h) * 4096; sp = p.in[3] + (size_t)b * RP; so = out + O_WKVS + (size_t)(b * 8 + h) * 4096; }
            rwkv_seq_item(p, lds, row0, T, h, si, sp, so, half);
        } else { const int j = cur - 128 - 1024, b = j >> 2, h = j & 3;
            hgrn_seq_item(p, lds, TP + b, 1, h, p.in[4] + (size_t)(b * 4 + h) * 16384, out + O_HGS + (size_t)(b * 4 + h) * 16384); }
    }
    if (!pr) {
        if (tidx() == 0) { while (__hip_atomic_load(arrive, __ATOMIC_ACQUIRE, __HIP_MEMORY_SCOPE_AGENT) < 128u) __builtin_amdgcn_s_sleep(8); __threadfence(); }
        __syncthreads();
    }
}

__device__ void phase_final_norm(const Params& p) {
    const int lane = tidx() & 63, wave = tidx() >> 6;
    const float* g = p.in[27];
    float4 gg[4];
#pragma unroll
    for (int i = 0; i < 4; ++i) gg[i] = *(const float4*)(g + i * 256 + lane * 4);
    int row = blockIdx.x * 8 + wave;
    float4 v[4];
    { const int r0 = row < M ? row : M - 1;
#pragma unroll
      for (int i = 0; i < 4; ++i) v[i] = *(const float4*)(p.out + (size_t)r0 * D + i * 256 + lane * 4); }
    for (; row < M; row += gridDim.x * 8) {
        const int rn = row + gridDim.x * 8 < M ? row + gridDim.x * 8 : row;
        float4 nv[4];
#pragma unroll
        for (int i = 0; i < 4; ++i) nv[i] = *(const float4*)(p.out + (size_t)rn * D + i * 256 + lane * 4);
        float ss = 0.f;
#pragma unroll
        for (int i = 0; i < 4; ++i) ss += v[i].x * v[i].x + v[i].y * v[i].y + v[i].z * v[i].z + v[i].w * v[i].w;
        ss = wave_sum(ss);
        const float rstd = rsqrtf(ss * (1.f / D) + 1e-6f);
        float* x = p.out + (size_t)row * D;
#pragma unroll
        for (int i = 0; i < 4; ++i) *(float4*)(x + i * 256 + lane * 4) = make_float4(v[i].x * rstd * gg[i].x, v[i].y * rstd * gg[i].y, v[i].z * rstd * gg[i].z, v[i].w * rstd * gg[i].w);
#pragma unroll
        for (int i = 0; i < 4; ++i) v[i] = nv[i];
    }
}

#ifndef COOP
#define COOP 1
#endif
constexpr int NPHASE = 8;

template <int MASK> __global__ void __launch_bounds__(NTHR) fwd_kernel(Params p_unused) {
    extern __shared__ __attribute__((aligned(16))) unsigned char lds[];
    PG8_LAS unsigned char* l3 = (PG8_LAS unsigned char*)lds;
    const int G = gridDim.x, c = blockIdx.x;
    if (tidx() < 30) ((unsigned long long*)(lds + PARAMS_OFF))[tidx()] = ((const unsigned long long*)__builtin_amdgcn_kernarg_segment_ptr())[tidx()];
    if (tidx() < 8) ((volatile LAS unsigned*)(lds + PARAMS_OFF + 256))[tidx()] = 0u;
    __syncthreads();
#define WS_PTR_() ((unsigned char*)(__attribute__((address_space(1))) unsigned char*)ld_u64_uniform(lds, 29))
    (void)xcd_barrier_post((unsigned*)(WS_PTR_() + WS_XBAR), (volatile LAS unsigned*)(lds + PARAMS_OFF + 256), (unsigned)G);
    if (c >= 160) (void)xcd_barrier_post((unsigned*)(WS_PTR_() + WS_XBAR2), (volatile LAS unsigned*)(lds + PARAMS_OFF + 272), (unsigned)(G - 160));
    if (((const int*)__builtin_amdgcn_kernarg_segment_ptr())[60] == 0x5a17) cg::this_grid().sync();
#define GRID_BARRIER() xcd_barrier_call((unsigned*)(WS_PTR_() + WS_XBAR), xb_xcc_id(), (volatile LAS unsigned*)(lds + PARAMS_OFF + 256), (unsigned)gridDim.x)
#if COOP
#define SEAM(k) do { if ((MASK & (1 << (k))) && (MASK >> ((k) + 1))) GRID_BARRIER(); } while (0)
#else
#define SEAM(k) do { } while (0)
#endif
    if (MASK & 1) { const Params p = load_params(lds); phase_prep(p, lds); } SEAM(0);
    if (MASK & 2) {
        const Params p = load_params(lds); unsigned char* ws = p.ws;
        pg8::Gemm g{(const bf16_t*)(ws + WS_H), (const bf16_t*)(ws + WS_BTIN), MPAD, NIN, D}; pg8::StaticOrder S; S.init(MPAD, NIN, G, c);
        EpiIn E{(bf16_t*)(ws + WS_PR), (bf16_t*)(ws + WS_QS), (float*)(ws + WS_F), (bf16_t*)(ws + WS_HI), (bf16_t*)(ws + WS_OG), (bf16_t*)p.out, (const float*)(ws + WS_MISC), p.out + O_SHP, p.out + O_SHS};
        pg8::gemm_phase<EpiIn, pg8::StaticOrder>(l3, g, S, E);
    } SEAM(1);
    if (MASK & 4) {
        { const Params p = load_params(lds); phase_lora_inputs(p); }
        GRID_BARRIER();
        { const Params p = load_params(lds); unsigned char* ws = p.ws;
          pg8::Gemm g{(const bf16_t*)(ws + WS_LIN), (const bf16_t*)(ws + WS_BTLO), MPAD, 1536, 256}; pg8::StaticOrder S; S.init(MPAD, 1536, G, c);
          EpiLora E{(bf16_t*)(ws + WS_LD), (bf16_t*)(ws + WS_AA), (bf16_t*)(ws + WS_GG), p.in[8], p.in[10]};
          pg8::gemm_phase<EpiLora, pg8::StaticOrder>(l3, g, S, E); }
        GRID_BARRIER();
    }
    if (MASK & 4) { const Params p = load_params(lds); phase_mix_seq(p, lds); }
#pragma nounroll
    for (int pass = (c >= 160 ? 0 : 1); pass < 2; ++pass) {
        unsigned char* ws = (unsigned char*)(__attribute__((address_space(1))) unsigned char*)ld_u64_uniform(lds, 29);
        unsigned* ctr = (unsigned*)(ws + WS_SUBBAR);
        const unsigned nb = (unsigned)(G - 160);
#define SEAM2(k) do { if (pass == 0) xcd_barrier_call((unsigned*)(WS_PTR_() + WS_XBAR2), xb_xcc_id(), (volatile LAS unsigned*)(lds + PARAMS_OFF + 272), (unsigned)(gridDim.x - 160)); else GRID_BARRIER(); } while (0)
        SEAM2(1);
        if (pass == 1) { { const Params p = load_params(lds); rwkv_post_pass(p); } GRID_BARRIER(); }
        {
            const Params p = load_params(lds);
            Order2 S; S.init(pass, D, G, c);
            bf16_t* mg = pass == 0 ? (bf16_t*)(ws + WS_MGS) - (size_t)TP * D : (bf16_t*)(ws + WS_MG);
            { pg8::Gemm g{(const bf16_t*)(ws + WS_OA), (const bf16_t*)(ws + WS_BTUPA), MPAD, D, 512}; OrderMerge SM; SM.o = S; EpiMerge2 E{mg, (const bf16_t*)p.out}; pg8::gemm_phase<EpiMerge2, OrderMerge>(l3, g, SM, E); }
        }
        SEAM2(2);
        {
            const Params p = load_params(lds);
            bf16_t* x1b = pass == 0 ? (bf16_t*)(ws + WS_X1BS) - (size_t)TP * D : (bf16_t*)(ws + WS_X1B);
            const bf16_t* mg = pass == 0 ? (const bf16_t*)(ws + WS_MGS) - (size_t)TP * D : (const bf16_t*)(ws + WS_MG);
            pg8::Gemm g{mg, (const bf16_t*)(ws + WS_BTOUT), MPAD, D, D}; Order2 S; S.init(pass, D, G, c);
            EpiOut E{p.in[0], p.in[1], p.out, x1b, (float*)(ws + WS_MISC + 4096)};
            pg8::gemm_phase<EpiOut, Order2>(l3, g, S, E);
        }
        SEAM2(3);
        {
            bf16_t* x1b = pass == 0 ? (bf16_t*)(ws + WS_X1BS) - (size_t)TP * D : (bf16_t*)(ws + WS_X1B);
            bf16_t* act = pass == 0 ? (bf16_t*)(ws + WS_ACTS) - (size_t)TP * DFF : (bf16_t*)(ws + WS_ACT);
            pg8::Gemm g{x1b, (const bf16_t*)(ws + WS_BTGU), MPAD, 2 * DFF, D}; Order2 S; S.init(pass, 2 * DFF, G, c);
            EpiGU E{act, (const float*)(ws + WS_MISC + 4096)};
            pg8::gemm_phase<EpiGU, Order2>(l3, g, S, E);
        }
        SEAM2(4);
        {
            const Params p = load_params(lds);
            bf16_t* act = pass == 0 ? (bf16_t*)(ws + WS_ACTS) - (size_t)TP * DFF : (bf16_t*)(ws + WS_ACT);
            pg8::Gemm g{act, (const bf16_t*)(ws + WS_BTDN), MPAD, D, DFF}; Order2 S; S.init(pass, D, G, c);
            EpiDown E{p.out};
            pg8::gemm_phase<EpiDown, Order2>(l3, g, S, E);
        }
#undef SEAM2
    }
    GRID_BARRIER();
    if (MASK & 128) { const Params p = load_params(lds); phase_final_norm(p); }
#undef SEAM
}

#if COOP
constexpr int NKERN = 1;
static const void* kern_ptr(int) { return (const void*)fwd_kernel<255>; }
#else
constexpr int NKERN = 8;
static const void* kern_ptr(int k) {
    switch (k) { case 0: return (const void*)fwd_kernel<1>; case 1: return (const void*)fwd_kernel<2>; case 2: return (const void*)fwd_kernel<4>; case 3: return (const void*)fwd_kernel<8>;
                 case 4: return (const void*)fwd_kernel<16>; case 5: return (const void*)fwd_kernel<32>; case 6: return (const void*)fwd_kernel<64>; default: return (const void*)fwd_kernel<128>; }
}
#endif
extern "C" void kernel_launch(void* const* d_in, const int* in_sizes, int n_in, void* d_out, int out_size, void* d_ws, size_t ws_size, hipStream_t stream) {
    static int grid = 0;
    if (grid == 0) {
        if (n_in != 28 || ws_size < WS_END4) { fprintf(stderr, "kernel_launch: unexpected n_in %d / ws_size %zu (need %zu)\n", n_in, ws_size, (size_t)WS_END4); grid = -1; return; }
        for (int k = 0; k < NKERN; ++k) if (hipFuncSetAttribute(kern_ptr(k), hipFuncAttributeMaxDynamicSharedMemorySize, LDS_BYTES) != hipSuccess) { fprintf(stderr, "kernel_launch: hipFuncSetAttribute failed\n"); grid = -1; return; }
        int dev = 0, cus = 0, per_cu = 0;
        (void)hipGetDevice(&dev); (void)hipDeviceGetAttribute(&cus, hipDeviceAttributeMultiprocessorCount, dev);
        (void)hipOccupancyMaxActiveBlocksPerMultiprocessor(&per_cu, kern_ptr(0), NTHR, LDS_BYTES);
        if (per_cu < 1) { fprintf(stderr, "kernel_launch: occupancy query says %d blocks per CU\n", per_cu); per_cu = 1; }
        grid = cus;
        (void)hipGetLastError();
    }
    if (grid < 0) return;
    (void)hipMemsetAsync((unsigned char*)d_ws + WS_XBAR, 0, (size_t)(WS_XBAR2 - WS_XBAR) + (size_t)XCD_BAR_WORDS * 4, stream);
    Params p{};
    for (int i = 0; i < 28; ++i) p.in[i] = (const float*)d_in[i];
    p.out = (float*)d_out; p.ws = (unsigned char*)d_ws;
#if COOP
    void* args[] = {&p};
    hipError_t e = hipLaunchCooperativeKernel(kern_ptr(0), dim3(grid), dim3(NTHR), args, LDS_BYTES, stream);
    if (e != hipSuccess) fprintf(stderr, "cooperative launch failed: %s (grid %d)\n", hipGetErrorString(e), grid);
#else
    for (int ph = 0; ph < NPHASE; ++ph) { void* args[] = {&p}; (void)hipLaunchKernel(kern_ptr(ph), dim3(grid), dim3(NTHR), args, LDS_BYTES, stream); }
#endif
}
```

```cpp
#include <hip/hip_runtime.h>
#include <hip/hip_cooperative_groups.h>
#include <cstdio>
namespace cg = cooperative_groups;
__device__ __forceinline__ int tidx() { int t = __builtin_amdgcn_workitem_id_x(); asm volatile("" : "+v"(t)); return t; }
namespace pg8 {
#define PG8_LAS __attribute__((address_space(3)))
typedef unsigned short bf16_t;
typedef short bf16x8 __attribute__((ext_vector_type(8)));
typedef float f32x4 __attribute__((ext_vector_type(4)));
typedef unsigned u32x4 __attribute__((ext_vector_type(4)));
constexpr int BM = 256, BK = 64, HALF = 128, HTB = HALF * BK * 2  , STAGE_BYTES = 8 * HTB, NXCD = 8, WGM = 8;

__host__ __device__ __forceinline__ int lds_byte(int r, int c) { const int st = (r >> 4) * 2 + (c >> 5), rr = r & 15, cc = c & 31, ob = rr * 64 + cc * 2; return st * 1024 + (ob ^ (((ob >> 9) & 1) << 5)); }
__host__ __device__ __forceinline__ void stage_rc(int b, int& R, int& C) { const int st = b / 1024, sb = b % 1024, swz = sb ^ (((sb >> 9) & 1) << 5); R = (st >> 1) * 16 + swz / 64; C = (st & 1) * 32 + (swz % 64) / 2; }
__host__ __device__ __forceinline__ int perm32(int rho) { const int n = rho >> 4, i = rho & 15; return 8 * (i >> 2) + 4 * n + (i & 3); }

struct Unit { int pm, pn; };
struct Gemm { const bf16_t* A; const bf16_t* Bt; int M, N, K; };

struct StaticOrder {
    int nM, nN, nwg, G, c;
    __host__ __device__ void init(int M, int N, int G_, int c_) { nM = M / BM; nN = N / BM; nwg = nM * nN; G = G_; c = c_; }
    __host__ __device__ bool next(int i, Unit& u) const {
        const long L = (long)i * G + c; if (L >= nwg) return false;
        int wgid = (int)L; { const int q = nwg / NXCD, r = nwg % NXCD, xcd = wgid % NXCD, off = wgid / NXCD; wgid = (xcd < r ? xcd * (q + 1) : r * (q + 1) + (xcd - r) * q) + off; }
        const int nig = WGM * nN, gid = wgid / nig, fm = gid * WGM, gsz = (nM - fm) < WGM ? (nM - fm) : WGM;
        u.pm = fm + ((wgid % nig) % gsz); u.pn = (wgid % nig) / gsz; return true;
    }
    __device__ __forceinline__ void a_ready(const Unit&) const {}
    __device__ __forceinline__ void done(const Unit&) const {}
};
typedef float f32x2 __attribute__((ext_vector_type(2)));
typedef __bf16 bf16x2n __attribute__((ext_vector_type(2)));
__device__ __forceinline__ unsigned cvt_pk_bf16(float lo, float hi) { const f32x2 v = {lo, hi}; return __builtin_bit_cast(unsigned, __builtin_convertvector(v, bf16x2n)); }
template <class Epi, class Sched>
__device__ __forceinline__ void gemm_phase(PG8_LAS unsigned char* lds, const Gemm g, const Sched& S, const Epi& E) {
    const int tid = tidx(), wid = __builtin_amdgcn_readfirstlane(tid >> 6), lane = tid & 63, wr = wid >> 2, wc = wid & 3, fr = lane & 15, fq = lane >> 4;
    const int K = g.K, nt = K / BK;
    unsigned voffA[2], voffB[2];
#pragma unroll
    for (int i = 0; i < 2; ++i) { int R, C; stage_rc(tid * 16 + i * 8192, R, C); const int Rb = Epi::PERM ? ((R & ~31) + perm32(R & 31)) : R;
        voffA[i] = (unsigned)(R * K + C) * 2u; voffB[i] = (unsigned)(Rb * K + C) * 2u; }
    const size_t kstep = (size_t)(BK * 2);
    const size_t hstep = (size_t)HALF * K * 2;
    const size_t tstep = 2 * hstep;
    const unsigned ldsw = (unsigned)wid * 1024u;
    const int aoff = lds_byte(wr * 64 + fr, fq * 8), boff = lds_byte(wc * 32 + fr, fq * 8);
#define PG8_SA(b, h) (((b) * 2 + (h)) * HTB)
#define PG8_SB(b, h) ((4 + (b) * 2 + (h)) * HTB)
#define PG8_STAGE(bufoff, gbase, voff) do { _Pragma("unroll") for (int _i = 0; _i < 2; ++_i) \
        __builtin_amdgcn_global_load_lds((const unsigned*)((const char*)(gbase) + (voff)[_i]), (PG8_LAS unsigned*)(lds + (bufoff) + ldsw + _i * 8192), 16, 0, 0); } while (0)
#define PG8_LDA(dst, b, h) do { _Pragma("unroll") for (int m = 0; m < 4; ++m) _Pragma("unroll") for (int k = 0; k < 2; ++k) dst[m][k] = *(const PG8_LAS bf16x8*)(lds + PG8_SA(b, h) + aoff + m * 2048 + k * 1024); } while (0)
#define PG8_LDB(dst, b, h) do { _Pragma("unroll") for (int n = 0; n < 2; ++n) _Pragma("unroll") for (int k = 0; k < 2; ++k) dst[n][k] = *(const PG8_LAS bf16x8*)(lds + PG8_SB(b, h) + boff + n * 2048 + k * 1024); } while (0)
#define PG8_MMA(ai, bj, At, Bt) do { __builtin_amdgcn_s_setprio(1); _Pragma("unroll") for (int m = 0; m < 4; ++m) _Pragma("unroll") for (int n = 0; n < 2; ++n) _Pragma("unroll") for (int k = 0; k < 2; ++k) \
        acc[ai][bj][m][n] = __builtin_amdgcn_mfma_f32_16x16x32_bf16(Bt[n][k], At[m][k], acc[ai][bj][m][n], 0, 0, 0); __builtin_amdgcn_s_setprio(0); } while (0)
#define PG8_WAIT_V(n) asm volatile("s_waitcnt vmcnt(" #n ")" ::: "memory")
#define PG8_WAIT_L(n) asm volatile("s_waitcnt lgkmcnt(" #n ")" ::: "memory")
#define PG8_BAR __builtin_amdgcn_s_barrier()
#define PG8_SCHED __builtin_amdgcn_sched_barrier(0)
    Unit cur, nxt; int ui = 0;
    if (!S.next(0, cur)) return;
    f32x4 acc[2][2][4][2];
#pragma unroll
    for (int a = 0; a < 2; ++a)
#pragma unroll
        for (int b = 0; b < 2; ++b)
#pragma unroll
            for (int m = 0; m < 4; ++m)
#pragma unroll
                for (int n = 0; n < 2; ++n) acc[a][b][m][n] = (f32x4){0.f, 0.f, 0.f, 0.f};
    bf16x8 At[4][2], B0[2][2], B1[2][2];
    const char* cA = (const char*)g.A + (size_t)cur.pm * tstep; const char* cB = (const char*)g.Bt + (size_t)cur.pn * tstep;
    S.a_ready(cur);
    PG8_STAGE(PG8_SB(0, 0), cB, voffB); PG8_STAGE(PG8_SA(0, 0), cA, voffA); PG8_STAGE(PG8_SB(0, 1), cB + hstep, voffB); PG8_STAGE(PG8_SA(0, 1), cA + hstep, voffA);
    if (wr == 1) PG8_BAR;
    PG8_WAIT_V(4); PG8_BAR;
    PG8_STAGE(PG8_SB(1, 0), cB + kstep, voffB); PG8_STAGE(PG8_SA(1, 0), cA + kstep, voffA); PG8_STAGE(PG8_SB(1, 1), cB + hstep + kstep, voffB);
    PG8_WAIT_V(6); PG8_BAR;
    for (;;) {
        const bool has_next = S.next(ui + 1, nxt);
        const char* nA = has_next ? (const char*)g.A + (size_t)nxt.pm * tstep : cA; const char* nB = has_next ? (const char*)g.Bt + (size_t)nxt.pn * tstep : cB;
        for (int t = 0; t < nt; t += 2) {
            const bool last = (t == nt - 2);
            const char* a1 = cA + (size_t)(t + 1) * kstep;
            const char* a2 = last ? nA : cA + (size_t)(t + 2) * kstep; const char* b2 = last ? nB : cB + (size_t)(t + 2) * kstep;
            const char* a3 = a2 + kstep; const char* b3 = b2 + kstep;
            if (last && has_next) S.a_ready(nxt);
            PG8_LDB(B0, 0, 0); PG8_SCHED; PG8_LDA(At, 0, 0); PG8_STAGE(PG8_SA(1, 1), a1 + hstep, voffA);
            PG8_WAIT_L(8); PG8_BAR; PG8_WAIT_L(0); PG8_MMA(0, 0, At, B0); PG8_BAR; PG8_SCHED;
            PG8_LDB(B1, 0, 1); PG8_STAGE(PG8_SB(0, 0), b2, voffB);
            PG8_BAR; PG8_WAIT_L(0); PG8_MMA(0, 1, At, B1); PG8_BAR;
            PG8_LDA(At, 0, 1); PG8_STAGE(PG8_SA(0, 0), a2, voffA);
            PG8_BAR; PG8_WAIT_L(0); PG8_MMA(1, 0, At, B0); PG8_BAR; PG8_SCHED;
            PG8_STAGE(PG8_SB(0, 1), b2 + hstep, voffB);
            PG8_WAIT_V(6); PG8_BAR; PG8_MMA(1, 1, At, B1); PG8_BAR;
            PG8_LDB(B0, 1, 0); PG8_SCHED; PG8_LDA(At, 1, 0); PG8_STAGE(PG8_SA(0, 1), a2 + hstep, voffA);
            PG8_WAIT_L(8); PG8_BAR; PG8_WAIT_L(0); PG8_MMA(0, 0, At, B0); PG8_BAR; PG8_SCHED;
            PG8_LDB(B1, 1, 1); PG8_STAGE(PG8_SB(1, 0), b3, voffB);
            PG8_BAR; PG8_WAIT_L(0); PG8_MMA(0, 1, At, B1); PG8_BAR;
            PG8_LDA(At, 1, 1); PG8_STAGE(PG8_SA(1, 0), a3, voffA);
            PG8_BAR; PG8_WAIT_L(0); PG8_MMA(1, 0, At, B0); PG8_BAR; PG8_SCHED;
            PG8_STAGE(PG8_SB(1, 1), b3 + hstep, voffB);
            PG8_WAIT_V(6); PG8_BAR; PG8_MMA(1, 1, At, B1); PG8_BAR;
        }
        if constexpr (!Epi::AFTER_DRAIN) { E(acc, cur, wr, wc, fr, fq); S.done(cur); }
        if (!has_next) break;
#pragma unroll
        for (int a = 0; a < 2; ++a)
#pragma unroll
            for (int b = 0; b < 2; ++b)
#pragma unroll
                for (int m = 0; m < 4; ++m)
#pragma unroll
                    for (int n = 0; n < 2; ++n) acc[a][b][m][n] = (f32x4){0.f, 0.f, 0.f, 0.f};
        cur = nxt; cA = nA; cB = nB; ++ui;
    }
    PG8_WAIT_V(0);
    if (wr == 0) PG8_BAR;
    PG8_BAR;
    if constexpr (Epi::AFTER_DRAIN) { E.fused(acc, cur, wr, wc, fr, fq, lds, wid, lane); S.done(cur); }
#undef PG8_SA
#undef PG8_SB
#undef PG8_STAGE
#undef PG8_LDA
#undef PG8_LDB
#undef PG8_MMA
#undef PG8_WAIT_V
#undef PG8_WAIT_L
#undef PG8_BAR
#undef PG8_SCHED
}
}


using pg8::bf16_t; using pg8::bf16x8; using pg8::f32x4; using pg8::u32x4; using pg8::Unit; using pg8::cvt_pk_bf16;
typedef unsigned u32x2 __attribute__((ext_vector_type(2)));

constexpr int D = 1024, TP = 16384, TSMP = 128, M = TP + TSMP, MPAD = 16640, SEQ = 2048;
constexpr int RP = 1792, NIN = 5888, DFF = 2816;
constexpr int NTHR = 512;
constexpr int LDS_BYTES = 140 * 1024;

constexpr size_t O_Y = 0, O_WKVP = (size_t)M * D, O_SHP = O_WKVP + 8 * 8 * 64 * 64, O_HGP = O_SHP + 8 * RP,
                 O_WKVS = O_HGP + 8 * 4 * 128 * 128, O_SHS = O_WKVS + (size_t)128 * 8 * 64 * 64, O_HGS = O_SHS + 128 * RP;
constexpr size_t WS_BTIN = 0, WS_BTUPA = WS_BTIN + (size_t)NIN * D * 2, WS_BTUPB = WS_BTUPA + (size_t)D * 512 * 2, WS_BTOUT = WS_BTUPB + (size_t)D * 512 * 2,
                 WS_BTGU = WS_BTOUT + (size_t)D * D * 2, WS_BTDN = WS_BTGU + (size_t)2 * DFF * D * 2, WS_MISC = WS_BTDN + (size_t)D * DFF * 2,
                 WS_H = WS_MISC + 262144, WS_PR = WS_H + (size_t)MPAD * D * 2, WS_QS = WS_PR + (size_t)MPAD * RP * 2, WS_F = WS_QS + (size_t)MPAD * 512 * 2,
                 WS_HI = WS_F + (size_t)MPAD * 512 * 4, WS_OG = WS_HI + (size_t)MPAD * 512 * 2, WS_OA = WS_OG + (size_t)MPAD * 512 * 2,
                 WS_OB = WS_OA + (size_t)MPAD * 512 * 2, WS_END = WS_OB + (size_t)MPAD * 512 * 2;
constexpr size_t WS_MG = WS_H, WS_ACT = WS_PR, WS_X1B = WS_OA;
constexpr size_t WS_ACTS = WS_END, WS_X1BS = WS_ACTS + (size_t)256 * DFF * 2, WS_END2 = WS_X1BS + (size_t)256 * D * 2;
constexpr size_t WS_SUBBAR = WS_MISC + 196608;
constexpr size_t WS_XBAR2 = WS_MISC + 229376;
constexpr size_t WS_XBAR = WS_MISC + 212992;
constexpr size_t WS_LIN = WS_OA;
constexpr size_t WS_LD = WS_H, WS_AA = WS_H + (size_t)MPAD * 512 * 2;
constexpr size_t WS_GG = WS_END2, WS_MGS = WS_GG + (size_t)MPAD * 512 * 2, WS_BTLO = WS_MGS + (size_t)256 * D * 2, WS_END3 = WS_BTLO + (size_t)1536 * 256 * 2;
constexpr size_t WS_BON = WS_END3, WS_END4 = WS_BON + (size_t)TP * 8 * 4;
static_assert(WS_END4 <= (size_t)256 * 1024 * 1024, "workspace 4");
static_assert((size_t)MPAD * DFF * 2 <= WS_OA - WS_PR, "ACT alias");
static_assert(WS_END2 <= (size_t)256 * 1024 * 1024, "workspace");

struct Params {
    const float* in[28];
    float* out;
    unsigned char* ws;
    int pad0, pad1;
};


#define XB_TMO      128
#define XB_XCNT(j)  (256  + 64 * (j))
#define XB_XSUB(j)  (1280 + 64 * (j))
#define XB_XGEN(j)  (2304 + 64 * (j))
#define XB_TOP      3328
#define XB_TOPGEN   3392
#define XCD_BAR_WORDS 3456
#define XB_SPIN_CAP (1u << 18)
#ifndef LAS
#define LAS __attribute__((address_space(3)))
#endif

__device__ __forceinline__ unsigned xb_ld(unsigned* p)              { return __hip_atomic_load(p, __ATOMIC_RELAXED, __HIP_MEMORY_SCOPE_AGENT); }
__device__ __forceinline__ unsigned xb_add(unsigned* p, unsigned v) { return __hip_atomic_fetch_add(p, v, __ATOMIC_RELAXED, __HIP_MEMORY_SCOPE_AGENT); }
__device__ __forceinline__ unsigned xb_xcc_id() { return (unsigned)__builtin_amdgcn_s_getreg((3 << 11) | 20) & 0xFu; }
#define XB_SPIN(cond, bar) do { unsigned _sp = 0; while (cond) { __builtin_amdgcn_s_sleep(1); \
    if ((++_sp & 255u) == 0u) { if (xb_ld(&(bar)[XB_TMO])) break; if (_sp > XB_SPIN_CAP) { atomicAdd(&(bar)[XB_TMO], 1u); break; } } } } while (0)

struct XcdBarrier {
    unsigned nexp;
    unsigned* bar; unsigned x;
    volatile LAS unsigned* st;
};

__device__ __forceinline__ XcdBarrier xcd_barrier_post(unsigned* bar, volatile LAS unsigned* st, unsigned nexp) {
    XcdBarrier b; b.nexp = nexp; b.bar = bar; b.x = xb_xcc_id(); b.st = st;
    if (threadIdx.x == 0) (void)xb_add(&bar[XB_XCNT(b.x)], 1u);
    return b;
}
__device__ __forceinline__ void xcd_barrier_complete(unsigned* bar, unsigned x, unsigned& nloc, unsigned& nx, unsigned G) {
    unsigned sum, cnt, mine, sp = 0u;
    for (;;) {
        sum = 0u; cnt = 0u; mine = 0u;
#pragma unroll
        for (unsigned j = 0; j < 16; ++j) { const unsigned c = xb_ld(&bar[XB_XCNT(j)]); sum += c; cnt += (c > 0u) ? 1u : 0u; mine = (j == x) ? c : mine; }
        if (sum == G) break;
        __builtin_amdgcn_s_sleep(1);
        if ((++sp & 255u) == 0u) { if (xb_ld(&bar[XB_TMO])) break; if (sp > XB_SPIN_CAP) { atomicAdd(&bar[XB_TMO], 1u); break; } }
    }
    nloc = mine > 0u ? mine : 1u; nx = cnt > 0u ? cnt : 1u;
}

__device__ __forceinline__ void xcd_barrier(const XcdBarrier& b) {
    asm volatile("s_waitcnt vmcnt(0)" ::: "memory");
    __syncthreads();
    if (threadIdx.x == 0) {
        unsigned* bar = b.bar;
        __builtin_amdgcn_s_waitcnt(0);
        unsigned nloc = b.st[0], nx = b.st[1];
        if (nloc == 0u) { xcd_barrier_complete(bar, b.x, nloc, nx, b.nexp); b.st[0] = nloc; b.st[1] = nx; }
        const unsigned old = xb_add(&bar[XB_XSUB(b.x)], 1u);
        const unsigned gen = old / nloc;
        if (old + 1u == (gen + 1u) * nloc) {
            __builtin_amdgcn_fence(__ATOMIC_RELEASE, "agent");
            asm volatile("s_waitcnt vmcnt(0)" ::: "memory");
            const unsigned og = xb_add(&bar[XB_TOP], 1u);
            const unsigned tg = og / nx;
            if (og + 1u == (tg + 1u) * nx) xb_add(&bar[XB_TOPGEN], 1u);
            else XB_SPIN(xb_ld(&bar[XB_TOPGEN]) == tg, bar);
            __builtin_amdgcn_fence(__ATOMIC_ACQUIRE, "agent");
            xb_add(&bar[XB_XGEN(b.x)], 1u);
            asm volatile("s_waitcnt vmcnt(0)" ::: "memory");
        } else {
            XB_SPIN(xb_ld(&bar[XB_XGEN(b.x)]) == gen, bar);
            __builtin_amdgcn_fence(__ATOMIC_ACQUIRE, "agent");
            asm volatile("s_waitcnt vmcnt(0)" ::: "memory");
        }
    }
    __syncthreads();
}


__device__ __attribute__((noinline)) void xcd_barrier_call(unsigned* bar, unsigned x, volatile LAS unsigned* st, unsigned nexp) { XcdBarrier b; b.nexp = nexp; b.bar = bar; b.x = x; b.st = st; xcd_barrier(b); }

constexpr int PARAMS_OFF = LDS_BYTES - 512;
__device__ __forceinline__ unsigned long long ld_u64_uniform(const unsigned char* lds, int i) {
    const unsigned long long v = ((const unsigned long long*)(lds + PARAMS_OFF))[i];
    const unsigned lo = __builtin_amdgcn_readfirstlane((unsigned)v), hi = __builtin_amdgcn_readfirstlane((unsigned)(v >> 32));
    return ((unsigned long long)hi << 32) | lo;
}
__device__ __forceinline__ Params load_params(const unsigned char* lds) {
    Params q;
#pragma unroll
    for (int i = 0; i < 28; ++i) q.in[i] = (const float*)(const __attribute__((address_space(1))) float*)ld_u64_uniform(lds, i);
    q.out = (float*)(__attribute__((address_space(1))) float*)ld_u64_uniform(lds, 28); q.ws = (unsigned char*)(__attribute__((address_space(1))) unsigned char*)ld_u64_uniform(lds, 29); q.pad0 = 0; q.pad1 = 0;
    return q;
}

__device__ __forceinline__ float sigmoidf_(float x) { return __builtin_amdgcn_rcpf(1.f + __expf(-x)); }
__device__ __forceinline__ float bf2f(bf16_t v) { return __uint_as_float(((unsigned)v) << 16); }
__device__ __forceinline__ bf16_t f2bf(float f) { unsigned u = __float_as_uint(f); u += 0x7FFFu + ((u >> 16) & 1u); return (bf16_t)(u >> 16); }
template <int CTRL> __device__ __forceinline__ float dppf(float v) { return __builtin_bit_cast(float, __builtin_amdgcn_update_dpp(0, __builtin_bit_cast(int, v), CTRL, 0xF, 0xF, true)); }
__device__ __forceinline__ float red8(float v) { v += dppf<0xB1>(v); v += dppf<0x4E>(v); v += dppf<0x141>(v); return v; }
__device__ __forceinline__ float red16(float v) { v = red8(v); v += dppf<0x140>(v); return v; }
__device__ __forceinline__ float rdl(float v, int l) { return __builtin_bit_cast(float, __builtin_amdgcn_readlane(__builtin_bit_cast(int, v), l)); }
__device__ __forceinline__ float wave_sum(float v) { v = red16(v); return (rdl(v, 0) + rdl(v, 16)) + (rdl(v, 32) + rdl(v, 48)); }
__device__ __forceinline__ float fast_tanh(float x) { return 1.f - 2.f * __builtin_amdgcn_rcpf(1.f + __expf(2.f * x)); }
typedef float f2 __attribute__((ext_vector_type(2)));

struct TileDesc { const float* src; const float* kscale; bf16_t* dst; int K, N, kt, nt, mode; };
__device__ __forceinline__ TileDesc tile_desc(const Params& p, int t) {
    unsigned char* ws = p.ws; TileDesc d; d.kscale = nullptr; d.mode = 0;
    if (t < 1472) { d.src = p.in[6]; d.K = D; d.N = NIN; d.kt = t / 92; d.nt = t % 92; d.dst = (bf16_t*)(ws + WS_BTIN); }
    else if (t < 1600) { const int u = t - 1472; d.src = p.in[18]; d.K = 512; d.N = D; d.kt = u / 16; d.nt = u % 16; d.dst = (bf16_t*)(ws + WS_BTUPA); }
    else if (t < 1728) { const int u = t - 1600; d.src = p.in[21]; d.K = 512; d.N = D; d.kt = u / 16; d.nt = u % 16; d.dst = (bf16_t*)(ws + WS_BTUPB); }
    else if (t < 1984) { const int u = t - 1728; d.src = p.in[22]; d.K = D; d.N = D; d.kt = u / 16; d.nt = u % 16; d.dst = (bf16_t*)(ws + WS_BTOUT); }
    else if (t < 2688) { const int u = t - 1984; d.src = p.in[24]; d.K = D; d.N = DFF; d.kt = u / 44; d.nt = u % 44; d.dst = (bf16_t*)(ws + WS_BTGU); d.mode = 1; d.kscale = p.in[23]; }
    else if (t < 3392) { const int u = t - 2688; d.src = p.in[25]; d.K = D; d.N = DFF; d.kt = u / 44; d.nt = u % 44; d.dst = (bf16_t*)(ws + WS_BTGU); d.mode = 2; d.kscale = p.in[23]; }
    else { const int u = t - 3392; d.src = p.in[26]; d.K = DFF; d.N = D; d.kt = u / 16; d.nt = u % 16; d.dst = (bf16_t*)(ws + WS_BTDN); }
    return d;
}
__device__ void phase_prep(const Params& p, unsigned char* lds) {
    float* tile = (float*)lds;
    unsigned char* ws = p.ws;
    {
        const int tid = tidx(), li = tid >> 3, j0 = (tid & 7) * 8;
        int t = blockIdx.x;
        TileDesc d = tile_desc(p, t < 4096 ? t : 4095);
        const float* s0 = d.src + (size_t)(d.kt * 64 + li) * d.N + d.nt * 64 + j0;
        float4 a = *(const float4*)s0, b = *(const float4*)(s0 + 4);
        float sc = d.kscale ? d.kscale[d.kt * 64 + li] : 1.f;
        for (; t < 4096; t += gridDim.x) {
            const int tn = t + gridDim.x < 4096 ? t + gridDim.x : t;
            const TileDesc dn = tile_desc(p, tn);
            const float* sn = dn.src + (size_t)(dn.kt * 64 + li) * dn.N + dn.nt * 64 + j0;
            const float4 na = *(const float4*)sn, nb = *(const float4*)(sn + 4);
            const float nsc = dn.kscale ? dn.kscale[dn.kt * 64 + li] : 1.f;
            float* tw = tile + li * 65 + j0;
            tw[0] = a.x * sc; tw[1] = a.y * sc; tw[2] = a.z * sc; tw[3] = a.w * sc; tw[4] = b.x * sc; tw[5] = b.y * sc; tw[6] = b.z * sc; tw[7] = b.w * sc;
            asm volatile("s_waitcnt lgkmcnt(0)" ::: "memory"); __builtin_amdgcn_s_barrier(); asm volatile("" ::: "memory");
            {
                const int n = tid >> 3, k0 = (tid & 7) * 8;
                float v[8];
#pragma unroll
                for (int kk = 0; kk < 8; ++kk) v[kk] = tile[(k0 + kk) * 65 + n];
                u32x4 w; w.x = cvt_pk_bf16(v[0], v[1]); w.y = cvt_pk_bf16(v[2], v[3]); w.z = cvt_pk_bf16(v[4], v[5]); w.w = cvt_pk_bf16(v[6], v[7]);
                const int ncol = d.nt * 64 + n;
                const int drow = d.mode == 0 ? ncol : ((ncol >> 7) * 256 + (d.mode == 2 ? 128 : 0) + (ncol & 127));
                *(u32x4*)(d.dst + (size_t)drow * d.K + d.kt * 64 + k0) = w;
            }
            asm volatile("s_waitcnt lgkmcnt(0)" ::: "memory"); __builtin_amdgcn_s_barrier(); asm volatile("" ::: "memory");
            d = dn; a = na; b = nb; sc = nsc;
        }
    }
    const int lane = tidx() & 63, wave = tidx() >> 6;
    const float* g = p.in[5];
    bf16_t* H = (bf16_t*)(ws + WS_H);
    {
        float4 gg[4];
#pragma unroll
        for (int i = 0; i < 4; ++i) gg[i] = *(const float4*)(g + i * 256 + lane * 4);
        int row = blockIdx.x * 8 + wave;
        float4 v[4];
        { const int r0 = row < M ? row : M - 1; const float* x = r0 < TP ? p.in[0] + (size_t)r0 * D : p.in[1] + (size_t)(r0 - TP) * D;
#pragma unroll
          for (int i = 0; i < 4; ++i) v[i] = *(const float4*)(x + i * 256 + lane * 4); }
        for (; row < M; row += gridDim.x * 8) {
            const int rn = row + gridDim.x * 8 < M ? row + gridDim.x * 8 : row;
            const float* xn = rn < TP ? p.in[0] + (size_t)rn * D : p.in[1] + (size_t)(rn - TP) * D;
            float4 nv[4];
#pragma unroll
            for (int i = 0; i < 4; ++i) nv[i] = *(const float4*)(xn + i * 256 + lane * 4);
            float ss = 0.f;
#pragma unroll
            for (int i = 0; i < 4; ++i) ss += v[i].x * v[i].x + v[i].y * v[i].y + v[i].z * v[i].z + v[i].w * v[i].w;
            ss = wave_sum(ss);
            const float rstd = rsqrtf(ss * (1.f / D) + 1e-6f);
#pragma unroll
            for (int i = 0; i < 4; ++i) { u32x2 w; w.x = cvt_pk_bf16(v[i].x * rstd * gg[i].x, v[i].y * rstd * gg[i].y); w.y = cvt_pk_bf16(v[i].z * rstd * gg[i].z, v[i].w * rstd * gg[i].w);
                *(u32x2*)(H + (size_t)row * D + i * 256 + lane * 4) = w; }
#pragma unroll
            for (int i = 0; i < 4; ++i) v[i] = nv[i];
        }
    }
    float* lb = (float*)(ws + WS_MISC); float* ssq = (float*)(ws + WS_MISC + 4096);
    const int gt = blockIdx.x * NTHR + tidx();
    if (gt < 512) lb[gt] = 1.f / (1.f + __expf(p.in[19][512 + gt] - p.in[19][gt]));
    for (int i = gt; i < MPAD; i += gridDim.x * NTHR) ssq[i] = 0.f;
    if (gt == 0) *(unsigned*)(ws + WS_SUBBAR) = 0u;
    {
        bf16_t* bl = (bf16_t*)(ws + WS_BTLO);
        for (int i = gt; i < 1536 * 256; i += gridDim.x * NTHR) {
            const int n = i >> 8, k = i & 255; float v = 0.f;
            if (n < 512) { if (k < 64) v = p.in[9][k * 512 + n]; }
            else if (n < 1024) { if (k >= 64 && k < 128) v = p.in[11][(k - 64) * 512 + (n - 512)]; }
            else { if (k >= 128) v = p.in[12][(k - 128) * 512 + (n - 1024)]; }
            bl[i] = f2bf(v);
        }
    }
}

typedef const f32x4 (&AccRef)[2][2][4][2];
__device__ __forceinline__ u32x4 pack8(const f32x4 a, const f32x4 b) { u32x4 w; w.x = cvt_pk_bf16(a[0], a[1]); w.y = cvt_pk_bf16(a[2], a[3]); w.z = cvt_pk_bf16(b[0], b[1]); w.w = cvt_pk_bf16(b[2], b[3]); return w; }
__device__ __forceinline__ void unpack8(const u32x4 w, f32x4& a, f32x4& b) {
    a[0] = __uint_as_float(w.x << 16); a[1] = __uint_as_float(w.x & 0xffff0000u); a[2] = __uint_as_float(w.y << 16); a[3] = __uint_as_float(w.y & 0xffff0000u);
    b[0] = __uint_as_float(w.z << 16); b[1] = __uint_as_float(w.z & 0xffff0000u); b[2] = __uint_as_float(w.w << 16); b[3] = __uint_as_float(w.w & 0xffff0000u); }

struct EpiIn {
    static constexpr bool PERM = true, AFTER_DRAIN = false;
    bf16_t* PR; bf16_t* QS; float* F; bf16_t* HI; bf16_t* OG; bf16_t* GATE; const float* lb; float* shp; float* shs;
    __device__ __forceinline__ void operator()(AccRef acc, const Unit& u, int wr, int wc, int fr, int fq) const {
        const int row0 = u.pm * 256 + wr * 64 + fr, cl = wc * 32 + 8 * fq;
        const int pn = u.pn;
#pragma unroll
        for (int ai = 0; ai < 2; ++ai)
#pragma unroll
            for (int m = 0; m < 4; ++m) {
                const int row = row0 + ai * 128 + m * 16;
#pragma unroll
                for (int bj = 0; bj < 2; ++bj) {
                    f32x4 v0 = acc[ai][bj][m][0], v1 = acc[ai][bj][m][1];
                    const int col = pn * 256 + bj * 128 + cl;
                    if (pn < 7) {
                        *(u32x4*)(PR + (size_t)row * RP + col) = pack8(v0, v1);
                        float* sp = nullptr;
                        if (row < TP) { if ((row & (SEQ - 1)) == SEQ - 1) sp = shp + (size_t)(row >> 11) * RP + col; }
                        else if (row < M) sp = shs + (size_t)(row - TP) * RP + col;
                        if (sp) { *(f32x4*)sp = v0; *(f32x4*)(sp + 4) = v1; }
                    } else if (pn < 15) {
                        const int hc = col - RP, ty = (pn - 7) >> 1, cc = hc - ty * 512;
                        if (ty == 0) {
#pragma unroll
                            for (int j = 0; j < 4; ++j) { v0[j] = v0[j] * sigmoidf_(v0[j]); v1[j] = v1[j] * sigmoidf_(v1[j]); }
                            *(u32x4*)(QS + (size_t)row * 512 + cc) = pack8(v0, v1);
                        } else if (ty == 1) {
                            const f32x4 l0 = *(const f32x4*)(lb + cc), l1 = *(const f32x4*)(lb + cc + 4);
#pragma unroll
                            for (int j = 0; j < 4; ++j) { v0[j] = l0[j] + (1.f - l0[j]) * sigmoidf_(v0[j]); v1[j] = l1[j] + (1.f - l1[j]) * sigmoidf_(v1[j]); }
                            *(f32x4*)(F + (size_t)row * 512 + cc) = v0; *(f32x4*)(F + (size_t)row * 512 + cc + 4) = v1;
                        } else if (ty == 2) {
                            *(u32x4*)(HI + (size_t)row * 512 + cc) = pack8(v0, v1);
                        } else {
#pragma unroll
                            for (int j = 0; j < 4; ++j) { v0[j] = sigmoidf_(v0[j]); v1[j] = sigmoidf_(v1[j]); }
                            *(u32x4*)(OG + (size_t)row * 512 + cc) = pack8(v0, v1);
                        }
                    } else {
                        const int gc = col - (RP + 2048);
#pragma unroll
                        for (int j = 0; j < 4; ++j) { v0[j] = sigmoidf_(v0[j]); v1[j] = sigmoidf_(v1[j]); }
                        if (row < M) *(u32x4*)(GATE + (size_t)row * 2048 + gc) = pack8(v0, v1);
                    }
                }
            }
    }
};

template <bool SECOND> struct EpiMerge {
    static constexpr bool PERM = true, AFTER_DRAIN = false;
    bf16_t* MG; const bf16_t* GATE;
    __device__ __forceinline__ void operator()(AccRef acc, const Unit& u, int wr, int wc, int fr, int fq) const {
        const int row0 = u.pm * 256 + wr * 64 + fr, cl = wc * 32 + 8 * fq;
#pragma unroll
        for (int ai = 0; ai < 2; ++ai)
#pragma unroll
            for (int mh = 0; mh < 2; ++mh) {
                u32x4 gv[2][2], pv[2][2];
#pragma unroll
                for (int mm = 0; mm < 2; ++mm) {
                    const int row = row0 + ai * 128 + (2 * mh + mm) * 16, rg = row < M ? row : M - 1;
#pragma unroll
                    for (int bj = 0; bj < 2; ++bj) {
                        const int col = u.pn * 256 + bj * 128 + cl;
                        gv[mm][bj] = *(const u32x4*)(GATE + (size_t)rg * 2048 + (SECOND ? 1024 : 0) + col);
                        if (SECOND) pv[mm][bj] = *(const u32x4*)(MG + (size_t)row * D + col);
                    }
                }
#pragma unroll
                for (int mm = 0; mm < 2; ++mm) {
                    const int m = 2 * mh + mm, row = row0 + ai * 128 + m * 16;
#pragma unroll
                    for (int bj = 0; bj < 2; ++bj) {
                        const int col = u.pn * 256 + bj * 128 + cl;
                        f32x4 g0, g1; unpack8(gv[mm][bj], g0, g1);
                        f32x4 v0 = acc[ai][bj][m][0] * g0, v1 = acc[ai][bj][m][1] * g1;
                        if (SECOND) { f32x4 p0, p1; unpack8(pv[mm][bj], p0, p1); v0 += p0; v1 += p1; }
                        *(u32x4*)(MG + (size_t)row * D + col) = pack8(v0, v1);
                    }
                }
                asm volatile("" ::: "memory");
            }
    }
};

struct EpiOut {
    static constexpr bool PERM = false, AFTER_DRAIN = false;
    const float* xp; const float* xs; float* X1; bf16_t* X1B; float* ssq;
    __device__ __forceinline__ void operator()(AccRef acc, const Unit& u, int wr, int wc, int fr, int fq) const {
        const int row0 = u.pm * 256 + wr * 64 + fr, col0 = u.pn * 256 + wc * 32 + 4 * fq;
#pragma unroll
        for (int ai = 0; ai < 2; ++ai)
#pragma unroll
            for (int mh = 0; mh < 2; ++mh) {
                f32x4 xv[2][2][2];
#pragma unroll
                for (int mm = 0; mm < 2; ++mm) {
                    const int row = row0 + ai * 128 + (2 * mh + mm) * 16, rc = row < M ? row : M - 1;
                    const float* xr = rc < TP ? xp + (size_t)rc * D : xs + (size_t)(rc - TP) * D;
#pragma unroll
                    for (int bj = 0; bj < 2; ++bj)
#pragma unroll
                        for (int n = 0; n < 2; ++n) xv[mm][bj][n] = *(const f32x4*)(xr + col0 + bj * 128 + n * 16);
                }
#pragma unroll
                for (int mm = 0; mm < 2; ++mm) {
                    const int m = 2 * mh + mm, row = row0 + ai * 128 + m * 16;
                    const bool ok = row < M;
                    float ss = 0.f;
#pragma unroll
                    for (int bj = 0; bj < 2; ++bj)
#pragma unroll
                        for (int n = 0; n < 2; ++n) {
                            const int col = col0 + bj * 128 + n * 16;
                            const f32x4 v = xv[mm][bj][n] + acc[ai][bj][m][n];
                            ss += v[0] * v[0] + v[1] * v[1] + v[2] * v[2] + v[3] * v[3];
                            if (ok) *(f32x4*)(X1 + (size_t)row * D + col) = v;
                            u32x2 w; w.x = cvt_pk_bf16(v[0], v[1]); w.y = cvt_pk_bf16(v[2], v[3]);
                            *(u32x2*)(X1B + (size_t)row * D + col) = w;
                        }
                    ss += __shfl_xor(ss, 16); ss += __shfl_xor(ss, 32);
                    if (fq == 0) atomicAdd(ssq + row, ss);
                }
                asm volatile("" ::: "memory");
            }
    }
};

struct EpiGU {
    static constexpr bool PERM = true, AFTER_DRAIN = false;
    bf16_t* ACT; const float* ssq;
    __device__ __forceinline__ void operator()(AccRef acc, const Unit& u, int wr, int wc, int fr, int fq) const {
        const int row0 = u.pm * 256 + wr * 64 + fr, col = u.pn * 128 + wc * 32 + 8 * fq;
#pragma unroll
        for (int ai = 0; ai < 2; ++ai)
#pragma unroll
            for (int m = 0; m < 4; ++m) {
                const int row = row0 + ai * 128 + m * 16;
                const float rstd = rsqrtf(ssq[row] * (1.f / D) + 1e-6f);
                f32x4 o[2];
#pragma unroll
                for (int n = 0; n < 2; ++n)
#pragma unroll
                    for (int j = 0; j < 4; ++j) { const float g = acc[ai][0][m][n][j] * rstd, uu = acc[ai][1][m][n][j] * rstd; o[n][j] = g * sigmoidf_(g) * uu; }
                *(u32x4*)(ACT + (size_t)row * DFF + col) = pack8(o[0], o[1]);
            }
    }
};

struct EpiDown {
    static constexpr bool PERM = false, AFTER_DRAIN = false;
    float* X;
    __device__ __forceinline__ void operator()(AccRef acc, const Unit& u, int wr, int wc, int fr, int fq) const {
        const int row0 = u.pm * 256 + wr * 64 + fr, col0 = u.pn * 256 + wc * 32 + 4 * fq;
#pragma unroll
        for (int ai = 0; ai < 2; ++ai)
#pragma unroll
            for (int mh = 0; mh < 2; ++mh) {
                f32x4 xv[2][2][2];
#pragma unroll
                for (int mm = 0; mm < 2; ++mm) {
                    const int row = row0 + ai * 128 + (2 * mh + mm) * 16, rc = row < M ? row : M - 1;
#pragma unroll
                    for (int bj = 0; bj < 2; ++bj)
#pragma unroll
                        for (int n = 0; n < 2; ++n) xv[mm][bj][n] = *(const f32x4*)(X + (size_t)rc * D + col0 + bj * 128 + n * 16);
                }
#pragma unroll
                for (int mm = 0; mm < 2; ++mm) {
                    const int m = 2 * mh + mm, row = row0 + ai * 128 + m * 16;
                    if (row < M) {
#pragma unroll
                        for (int bj = 0; bj < 2; ++bj)
#pragma unroll
                            for (int n = 0; n < 2; ++n) *(f32x4*)(X + (size_t)row * D + col0 + bj * 128 + n * 16) = xv[mm][bj][n] + acc[ai][bj][m][n];
                    }
                }
                asm volatile("" ::: "memory");
            }
    }
};


__device__ void phase_lora_inputs(const Params& p) {
    const bf16_t* PR = (const bf16_t*)(p.ws + WS_PR); bf16_t* LIN = (bf16_t*)(p.ws + WS_LIN);
    const float* mu = p.in[7]; const float* shs = p.in[3];
    for (int idx = blockIdx.x * NTHR + tidx(); idx < M * 32; idx += gridDim.x * NTHR) {
        const int row = idx >> 5, gq = idx & 31, col = 1536 + 8 * gq;
        const bool first = row >= TP || (row & (SEQ - 1)) == 0;
        const u32x4 cw = *(const u32x4*)(PR + (size_t)row * RP + col), pw = *(const u32x4*)(PR + (size_t)(row - (first ? 0 : 1)) * RP + col);
        const int sr = row >= TP ? row - TP : 0;
        const f32x4 z0 = *(const f32x4*)(shs + (size_t)sr * RP + col), z1 = *(const f32x4*)(shs + (size_t)sr * RP + col + 4);
        const f32x4 m0 = *(const f32x4*)(mu + col), m1 = *(const f32x4*)(mu + col + 4);
        f32x4 c0, c1, q0, q1; unpack8(cw, c0, c1); unpack8(pw, q0, q1);
        if (first) { if (row >= TP) { q0 = z0; q1 = z1; } else { q0 = (f32x4){0.f, 0.f, 0.f, 0.f}; q1 = q0; } }
        f32x4 s0 = c0 + m0 * (q0 - c0), s1 = c1 + m1 * (q1 - c1);
        if (gq < 8 || gq >= 16) {
            const bool th = gq < 8; const float ksc = th ? 2.f : 1.f, asc = th ? 2.f : 1.f, bsc = th ? -1.f : 0.f;
#pragma unroll
            for (int q = 0; q < 4; ++q) { s0[q] = asc * sigmoidf_(ksc * s0[q]) + bsc; s1[q] = asc * sigmoidf_(ksc * s1[q]) + bsc; }
        }
        *(u32x4*)(LIN + (size_t)row * 256 + 8 * gq) = pack8(s0, s1);
    }
}
struct EpiLora {
    static constexpr bool PERM = true, AFTER_DRAIN = false;
    bf16_t* LD; bf16_t* AA; bf16_t* GG; const float* w0; const float* a0;
    __device__ __forceinline__ void operator()(AccRef acc, const Unit& u, int wr, int wc, int fr, int fq) const {
        const int row0 = u.pm * 256 + wr * 64 + fr, cl = wc * 32 + 8 * fq, ty = u.pn >> 1;
#pragma unroll
        for (int bj = 0; bj < 2; ++bj) {
            const int cc = (u.pn & 1) * 256 + bj * 128 + cl;
            f32x4 b0 = {0.f, 0.f, 0.f, 0.f}, b1 = b0;
            if (ty == 0) { b0 = *(const f32x4*)(w0 + cc); b1 = *(const f32x4*)(w0 + cc + 4); } else if (ty == 1) { b0 = *(const f32x4*)(a0 + cc); b1 = *(const f32x4*)(a0 + cc + 4); }
#pragma unroll
            for (int ai = 0; ai < 2; ++ai)
#pragma unroll
                for (int m = 0; m < 4; ++m) {
                    const int row = row0 + ai * 128 + m * 16;
                    f32x4 v0 = acc[ai][bj][m][0] + b0, v1 = acc[ai][bj][m][1] + b1;
                    if (ty == 0) {
#pragma unroll
                        for (int q = 0; q < 4; ++q) { const float z0 = -v0[q], z1 = -v1[q];
                            v0[q] = -__expf(-(fmaxf(z0, 0.f) + __logf(1.f + __expf(-fabsf(z0)))) - 0.5f); v1[q] = -__expf(-(fmaxf(z1, 0.f) + __logf(1.f + __expf(-fabsf(z1)))) - 0.5f); }
                    } else if (ty == 1) {
#pragma unroll
                        for (int q = 0; q < 4; ++q) { v0[q] = sigmoidf_(v0[q]); v1[q] = sigmoidf_(v1[q]); }
                    }
                    const u32x4 w = pack8(v0, v1);
                    if (ty == 0) *(u32x4*)(LD + (size_t)row * 512 + cc) = w; else if (ty == 1) *(u32x4*)(AA + (size_t)row * 512 + cc) = w; else *(u32x4*)(GG + (size_t)row * 512 + cc) = w;
                }
        }
    }
};

__device__ __forceinline__ f32x4 mfma16(const bf16x8 a, const bf16x8 b, const f32x4 c) { return __builtin_amdgcn_mfma_f32_16x16x32_bf16(a, b, c, 0, 0, 0); }

__device__ void rwkv_seq_item(const Params& p, unsigned char* lds, int row0, int T, int h, const float* __restrict__ S_init, const float* __restrict__ shift_prev, float* __restrict__ S_out, int half) {
#define RW_BAR() do { asm volatile("s_waitcnt lgkmcnt(0)" ::: "memory"); __builtin_amdgcn_s_barrier(); asm volatile("" ::: "memory"); } while (0)
    constexpr int BUFB = 9 * 4096;
    float* sA = (float*)(lds + 73728);
    bf16_t* sTW = (bf16_t*)(lds + 77824); bf16_t* sAD = (bf16_t*)(lds + 80128); bf16_t* sSG = (bf16_t*)(lds + 82432);
    bf16_t* w2t = (bf16_t*)(lds + 86784); bf16_t* a2t = (bf16_t*)(lds + 96000); bf16_t* g2t = (bf16_t*)(lds + 105216);
    float* sMu = (float*)(lds + 122624); float* sCst = (float*)(lds + 124416);
    const int tid = tidx(), lane = tid & 63, wave = __builtin_amdgcn_readfirstlane(tid >> 6);
    const bf16_t* PR = (const bf16_t*)(p.ws + WS_PR);
    bf16_t* OA = (bf16_t*)(p.ws + WS_OA);
    const float *mu = p.in[7], *w0 = p.in[8], *w2 = p.in[9], *a0 = p.in[10], *a2 = p.in[11], *g2 = p.in[12], *k_k = p.in[13], *k_a = p.in[14], *r_k = p.in[15], *ln_g = p.in[16], *ln_b = p.in[17];
    __syncthreads();
    if (tid < 448) { const int j = tid; sMu[j] = mu[j < 64 ? 64 * h + j : (j < 128 ? 512 + 64 * h + (j - 64) : (j < 192 ? 1024 + 64 * h + (j - 128) : 1536 + (j - 192)))]; }
    else if (tid < 512) { const int c = tid - 448, cg = 64 * h + c; sCst[c] = k_k[cg]; sCst[64 + c] = k_a[cg]; sCst[128 + c] = r_k[cg]; sCst[192 + c] = ln_g[cg]; sCst[256 + c] = ln_b[cg]; sCst[320 + c] = w0[cg]; sCst[384 + c] = a0[cg]; }
    __syncthreads();
    const int NC = (T + 15) >> 4;
    if (wave < 4) {
        __builtin_amdgcn_s_setprio(2);
        const bool full = half < 0;
        const int rA = full ? 16 * wave + 2 * (lane >> 3) : 32 * half + 8 * wave + (lane >> 3), rB = full ? rA + 1 : rA, kp = lane & 7, lo = kp * 8;
        f2 SA[4], SB[4];
        if (S_init) {
            const f32x4 a0_ = *(const f32x4*)(S_init + rA * 64 + lo), a1_ = *(const f32x4*)(S_init + rA * 64 + lo + 4), b0_ = *(const f32x4*)(S_init + rB * 64 + lo), b1_ = *(const f32x4*)(S_init + rB * 64 + lo + 4);
            SA[0] = (f2){a0_[0], a0_[1]}; SA[1] = (f2){a0_[2], a0_[3]}; SA[2] = (f2){a1_[0], a1_[1]}; SA[3] = (f2){a1_[2], a1_[3]};
            SB[0] = (f2){b0_[0], b0_[1]}; SB[1] = (f2){b0_[2], b0_[3]}; SB[2] = (f2){b1_[0], b1_[1]}; SB[3] = (f2){b1_[2], b1_[3]};
        } else {
#pragma unroll
            for (int j = 0; j < 4; ++j) { SA[j] = (f2){0.f, 0.f}; SB[j] = (f2){0.f, 0.f}; }
        }
#define RW_LD(P, tt) P##d0 = *(const f32x4*)(bR + 3 * 1024 + (tt) * 64 + lo); P##d1 = *(const f32x4*)(bR + 3 * 1024 + (tt) * 64 + lo + 4); P##k0 = *(const f32x4*)(bR + 4 * 1024 + (tt) * 64 + lo); P##k1 = *(const f32x4*)(bR + 4 * 1024 + (tt) * 64 + lo + 4); \
        P##b0 = *(const f32x4*)(bR + 5 * 1024 + (tt) * 64 + lo); P##b1 = *(const f32x4*)(bR + 5 * 1024 + (tt) * 64 + lo + 4); P##q0 = *(const f32x4*)(bR + 1024 + (tt) * 64 + lo); P##q1 = *(const f32x4*)(bR + 1024 + (tt) * 64 + lo + 4); \
        P##r0 = *(const f32x4*)(bR + (tt) * 64 + lo); P##r1 = *(const f32x4*)(bR + (tt) * 64 + lo + 4); P##vv[0] = bR[2 * 1024 + (tt) * 64 + rA]; P##vv[1] = bR[2 * 1024 + (tt) * 64 + rB];
#define RW_ROW(S_, P, vsc, yout) {   \
        const f2 vvv = {vsc, vsc}; \
        const f2 t0_ = S_[0] * (f2){P##d0[0], P##d0[1]} + vvv * (f2){P##q0[0], P##q0[1]}, t1_ = S_[1] * (f2){P##d0[2], P##d0[3]} + vvv * (f2){P##q0[2], P##q0[3]}; \
        const f2 t2_ = S_[2] * (f2){P##d1[0], P##d1[1]} + vvv * (f2){P##q1[0], P##q1[1]}, t3_ = S_[3] * (f2){P##d1[2], P##d1[3]} + vvv * (f2){P##q1[2], P##q1[3]}; \
        const f2 sa2 = (S_[0] * (f2){P##k0[0], P##k0[1]} + S_[1] * (f2){P##k0[2], P##k0[3]}) + (S_[2] * (f2){P##k1[0], P##k1[1]} + S_[3] * (f2){P##k1[2], P##k1[3]}); \
        const float sa = -red8(sa2[0] + sa2[1]); const f2 sav = {sa, sa}; \
        S_[0] = t0_ + sav * (f2){P##b0[0], P##b0[1]}; S_[1] = t1_ + sav * (f2){P##b0[2], P##b0[3]}; S_[2] = t2_ + sav * (f2){P##b1[0], P##b1[1]}; S_[3] = t3_ + sav * (f2){P##b1[2], P##b1[3]}; \
        const f2 y2 = (S_[0] * (f2){P##r0[0], P##r0[1]} + S_[1] * (f2){P##r0[2], P##r0[3]}) + (S_[2] * (f2){P##r1[0], P##r1[1]} + S_[3] * (f2){P##r1[2], P##r1[3]}); \
        yout = red8(y2[0] + y2[1]); }
#define RW_STEP(P, tt) { float yA_, yB_; RW_ROW(SA, P, P##vv[0], yA_) ((float*)bR)[8 * 1024 + (tt) * 64 + rA] = yA_; if (full) { RW_ROW(SB, P, P##vv[1], yB_) ((float*)bR)[8 * 1024 + (tt) * 64 + rB] = yB_; } }
#define RW_PAIR(t) { RW_LD(B, (t) + 1) RW_STEP(A, (t)) RW_LD(A, ((t) + 2) & 15) RW_STEP(B, (t) + 1) }
        f32x4 Ad0, Ad1, Ak0, Ak1, Ab0, Ab1, Aq0, Aq1, Ar0, Ar1, Bd0, Bd1, Bk0, Bk1, Bb0, Bb1, Bq0, Bq1, Br0, Br1; f2 Avv, Bvv;
        for (int c = 0; c <= NC + 1; ++c) {
            if (c >= 1 && c <= NC) {
                const int cc = c - 1, nt = (T - 16 * cc) < 16 ? (T - 16 * cc) : 16;
                const float* bR = (const float*)(lds + (cc & 1) * BUFB);
                if (nt == 16) {
                    RW_LD(A, 0)
                    RW_PAIR(0) RW_PAIR(2) RW_PAIR(4) RW_PAIR(6)
                    RW_BAR();
                    RW_PAIR(8) RW_PAIR(10) RW_PAIR(12) RW_PAIR(14)
                    RW_BAR();
                } else {
                    for (int t = 0; t < nt; ++t) { RW_LD(A, t) RW_STEP(A, t) }
                    RW_BAR(); RW_BAR();
                }
            } else { RW_BAR(); RW_BAR(); }
        }
#undef RW_LD
#undef RW_ROW
#undef RW_STEP
#undef RW_PAIR
        __builtin_amdgcn_s_setprio(0);
        float* so = S_out + rA * 64 + lo;
        *(f32x4*)so = (f32x4){SA[0][0], SA[0][1], SA[1][0], SA[1][1]}; *(f32x4*)(so + 4) = (f32x4){SA[2][0], SA[2][1], SA[3][0], SA[3][1]};
        if (full) { *(f32x4*)(so + 64) = (f32x4){SB[0][0], SB[0][1], SB[1][0], SB[1][1]}; *(f32x4*)(so + 68) = (f32x4){SB[2][0], SB[2][1], SB[3][0], SB[3][1]}; }
    } else {
        const int ptid = tid - 256, pw = wave - 4;
        float* sBon = (float*)(lds + 126208);
        bf16_t* Yg = (bf16_t*)(p.ws + WS_OA); float* BONg = (float*)(p.ws + WS_BON);
        u32x4 pfc[2], pfp[2], pfl[2], pfcB[2], pfpB[2], pflB[2];
        const bf16_t* LDg = (const bf16_t*)(p.ws + WS_LD); const bf16_t* AAg = (const bf16_t*)(p.ws + WS_AA); const bf16_t* GGg = (const bf16_t*)(p.ws + WS_GG);
#define RW_COL(gi_) ((gi_) < 8 ? 64 * h + 8 * (gi_) : ((gi_) < 16 ? 512 + 64 * h + 8 * ((gi_) - 8) : ((gi_) < 24 ? 1024 + 64 * h + 8 * ((gi_) - 16) : 1536 + 8 * ((gi_) - 24))))
#define RW_GI(i_, j_) ((i_) == 0 ? (j_) : ((i_) == 1 ? ((j_) < 8 ? 16 + (j_) : 24 + (j_)) : ((i_) == 2 ? ((j_) < 8 ? 24 + (j_) : 32 + (j_)) : 48 + ((j_) & 7))))
#define RW_PREFETCH(cn) do { const int tb_ = 16 * (cn); const int ntn_ = (T - tb_) < 16 ? (T - tb_) : 16; const int t_ = (ptid >> 4) < ntn_ ? (ptid >> 4) : ntn_ - 1;   \
        const size_t row_ = (size_t)row0 + tb_ + t_; const size_t rowp_ = row_ - (tb_ + t_ > 0 ? 1 : 0); \
        _Pragma("unroll") for (int i_ = 0; i_ < 2; ++i_) { const int gi_ = (ptid & 15) + 8 * i_ * (1 + (((ptid & 15) < 8) ? 1 : 0));   \
            const int col_ = RW_COL(gi_); pfc[i_] = *(const u32x4*)(PR + row_ * RP + col_); pfp[i_] = *(const u32x4*)(PR + rowp_ * RP + col_); } \
        } while (0)
#define RW_PREFETCH_L(cn) do { const int tb_ = 16 * (cn); const int ntn_ = (T - tb_) < 16 ? (T - tb_) : 16; const int t2_ = ((ptid >> 3) & 15) < ntn_ ? ((ptid >> 3) & 15) : ntn_ - 1; \
        const size_t o_ = ((size_t)row0 + tb_ + t2_) * 512 + 64 * h + 8 * (ptid & 7); pfl[0] = *(const u32x4*)(((ptid >> 7) ? AAg : LDg) + o_); pfl[1] = *(const u32x4*)(GGg + o_); } while (0)
        RW_PREFETCH(0); RW_PREFETCH_L(0);
        if (NC > 1) { auto pf1 = [&](u32x4 (&pfc)[2], u32x4 (&pfp)[2], u32x4 (&pfl)[2]) __attribute__((always_inline)) { RW_PREFETCH(1); RW_PREFETCH_L(1); }; pf1(pfcB, pfpB, pflB); }
        auto prep_iter = [&](const int c, u32x4 (&pfc)[2], u32x4 (&pfp)[2], u32x4 (&pfl)[2]) __attribute__((always_inline)) {
            if (c >= 2) {
                const int cc = c - 2, nt = (T - 16 * cc) < 16 ? (T - 16 * cc) : 16;
                const float* bR = (const float*)(lds + (cc & 1) * BUFB);
                if (half >= 0) {
                    if (ptid < 8 * nt) {
                        const int t = ptid >> 3, c8 = 8 * (ptid & 7); const size_t grow = (size_t)row0 + 16 * cc + t;
                        if (((ptid & 7) >> 2) == half) *(u32x4*)(Yg + grow * 512 + 64 * h + c8) = pack8(*(const f32x4*)(bR + 8 * 1024 + t * 64 + c8), *(const f32x4*)(bR + 8 * 1024 + t * 64 + c8 + 4));
                        if (half == 0 && (ptid & 7) == 0) BONg[grow * 8 + h] = sBon[(cc & 1) * 16 + t];
                    }
                } else
                if (ptid < 8 * nt) {
                    const int t = ptid >> 3, c8 = 8 * (ptid & 7);
                    const f32x4 y0 = *(const f32x4*)(bR + 8 * 1024 + t * 64 + c8), y1 = *(const f32x4*)(bR + 8 * 1024 + t * 64 + c8 + 4);
                    const float mean = red8((y0[0] + y0[1]) + (y0[2] + y0[3]) + (y1[0] + y1[1]) + (y1[2] + y1[3])) * (1.f / 64.f);
                    const f32x4 d0 = y0 - mean, d1 = y1 - mean, dq = d0 * d0 + d1 * d1;
                    const float var = red8((dq[0] + dq[1]) + (dq[2] + dq[3])) * (1.f / 64.f);
                    const float rs = rsqrtf(var + 64e-5f);
                    const f32x4 lg0 = *(const f32x4*)(sCst + 192 + c8), lg1 = *(const f32x4*)(sCst + 192 + c8 + 4), lb0 = *(const f32x4*)(sCst + 256 + c8), lb1 = *(const f32x4*)(sCst + 256 + c8 + 4);
                    const f32x4 bv0 = *(const f32x4*)(bR + 7 * 1024 + t * 64 + c8), bv1 = *(const f32x4*)(bR + 7 * 1024 + t * 64 + c8 + 4), g0 = *(const f32x4*)(bR + 6 * 1024 + t * 64 + c8), g1 = *(const f32x4*)(bR + 6 * 1024 + t * 64 + c8 + 4);
                    const f32x4 o0 = (d0 * rs * lg0 + lb0 + bv0) * g0, o1 = (d1 * rs * lg1 + lb1 + bv1) * g1;
                    *(u32x4*)(OA + ((size_t)row0 + 16 * cc + t) * 512 + 64 * h + c8) = pack8(o0, o1);
                }
            }
            const bool act = c < NC;
            const int nt = act ? ((T - 16 * c) < 16 ? (T - 16 * c) : 16) : 0;
            float* bW = (float*)(lds + (c & 1) * BUFB);
            if (act) {
                {
                    const int t = ptid >> 4, j = ptid & 15;
                    if (t < nt) {
#pragma unroll
                        for (int i1 = 0; i1 < 2; ++i1) {
                            if (i1 == 0 || j < 8) {
                                const int gi = j + 16 * i1;
                                f32x4 c0, c1, p0, p1;
                                unpack8(pfc[i1], c0, c1);
                                if (16 * c + t == 0) { if (shift_prev) { const int col = RW_COL(gi); p0 = *(const f32x4*)(shift_prev + col); p1 = *(const f32x4*)(shift_prev + col + 4); } else { p0 = (f32x4){0.f, 0.f, 0.f, 0.f}; p1 = p0; } }
                                else unpack8(pfp[i1], p0, p1);
                                const f32x4 m0 = *(const f32x4*)(sMu + 8 * gi), m1 = *(const f32x4*)(sMu + 8 * gi + 4);
                                const f32x4 s0 = c0 + m0 * (p0 - c0), s1 = c1 + m1 * (p1 - c1);
                                float* d = bW + (gi >> 3) * 1024 + t * 64 + 8 * (gi & 7); *(f32x4*)d = s0; *(f32x4*)(d + 4) = s1;
                            }
                        }
                    }
                }
                if (c + 2 < NC) RW_PREFETCH(c + 2);
                    const int t2 = (ptid >> 3) & 15, c8 = 8 * (ptid & 7);
                    if (t2 < nt) {
                        f32x4 x0, x1; unpack8(pfl[0], x0, x1);
                        if (ptid >> 7) { *(f32x4*)(sA + t2 * 64 + c8) = x0; *(f32x4*)(sA + t2 * 64 + c8 + 4) = x1; }
                        else {
#pragma unroll
                            for (int q = 0; q < 4; ++q) { x0[q] = __expf(x0[q]); x1[q] = __expf(x1[q]); }
                            *(f32x4*)(bW + 3 * 1024 + t2 * 64 + c8) = x0; *(f32x4*)(bW + 3 * 1024 + t2 * 64 + c8 + 4) = x1;
                            f32x4 g0, g1; unpack8(pfl[1], g0, g1);
                            *(f32x4*)(bW + 6 * 1024 + t2 * 64 + c8) = g0; *(f32x4*)(bW + 6 * 1024 + t2 * 64 + c8 + 4) = g1;
                        }
                    }
                if (c + 2 < NC) RW_PREFETCH_L(c + 2);
            }
            RW_BAR();
            if (act && ptid < 8 * nt) {
                const int t = ptid >> 3, c8 = 8 * (ptid & 7);
                f32x4 k0 = *(const f32x4*)(bW + 1024 + t * 64 + c8), k1 = *(const f32x4*)(bW + 1024 + t * 64 + c8 + 4);
                const f32x4 a0v = *(const f32x4*)(sA + t * 64 + c8), a1v = *(const f32x4*)(sA + t * 64 + c8 + 4);
                const f32x4 r0 = *(const f32x4*)(bW + t * 64 + c8), r1 = *(const f32x4*)(bW + t * 64 + c8 + 4);
                const f32x4 v0 = *(const f32x4*)(bW + 2 * 1024 + t * 64 + c8), v1 = *(const f32x4*)(bW + 2 * 1024 + t * 64 + c8 + 4);
                const f32x4 kk0 = *(const f32x4*)(sCst + c8), kk1 = *(const f32x4*)(sCst + c8 + 4), ka0 = *(const f32x4*)(sCst + 64 + c8), ka1 = *(const f32x4*)(sCst + 64 + c8 + 4);
                const f32x4 rk0 = *(const f32x4*)(sCst + 128 + c8), rk1 = *(const f32x4*)(sCst + 128 + c8 + 4);
                f32x4 n0 = k0 * kk0, n1 = k1 * kk1;
                const f32x4 sq = n0 * n0 + n1 * n1;
                const float n2 = red8((sq[0] + sq[1]) + (sq[2] + sq[3]));
                const float inv = __builtin_amdgcn_rcpf(fmaxf(sqrtf(n2), 1e-12f));
                n0 *= inv; n1 *= inv;
                k0 = k0 * (1.f + (a0v - 1.f) * ka0); k1 = k1 * (1.f + (a1v - 1.f) * ka1);
                const f32x4 bs = r0 * k0 * rk0 + r1 * k1 * rk1;
                const float bon = red8((bs[0] + bs[1]) + (bs[2] + bs[3]));
                *(f32x4*)(bW + 1024 + t * 64 + c8) = k0; *(f32x4*)(bW + 1024 + t * 64 + c8 + 4) = k1;
                *(f32x4*)(bW + 4 * 1024 + t * 64 + c8) = n0; *(f32x4*)(bW + 4 * 1024 + t * 64 + c8 + 4) = n1;
                *(f32x4*)(bW + 5 * 1024 + t * 64 + c8) = n0 * a0v; *(f32x4*)(bW + 5 * 1024 + t * 64 + c8 + 4) = n1 * a1v;
                *(f32x4*)(bW + 7 * 1024 + t * 64 + c8) = v0 * bon; *(f32x4*)(bW + 7 * 1024 + t * 64 + c8 + 4) = v1 * bon;
                if ((ptid & 7) == 0) sBon[(c & 1) * 16 + t] = bon;
            }
            RW_BAR();
                };
        for (int c = 0; c <= NC + 1; c += 2) { prep_iter(c, pfc, pfp, pfl); if (c + 1 <= NC + 1) prep_iter(c + 1, pfcB, pfpB, pflB); }
        __builtin_amdgcn_s_setprio(0);
#undef RW_PREFETCH
#undef RW_PREFETCH_L
#undef RW_COL
#undef RW_GI
#undef RW_BAR
    }
    __syncthreads();
}

__device__ void hgrn_seq_item(const Params& p, unsigned char* lds, int row0, int T, int h, const float* __restrict__ S_init, float* __restrict__ S_out) {
    float* sF = (float*)lds; float* sQ = sF + 4096; float* sI = sQ + 4096; float* sO = sI + 4096;
    const int tid = tidx(), lane = tid & 63, wave = tid >> 6, col = tid >> 2, kp = tid & 3;
    const float* F = (const float*)(p.ws + WS_F); const bf16_t* QS = (const bf16_t*)(p.ws + WS_QS); const bf16_t* HI = (const bf16_t*)(p.ws + WS_HI);
    const bf16_t* OG = (const bf16_t*)(p.ws + WS_OG); bf16_t* OB = (bf16_t*)(p.ws + WS_OB); const float* norm_g = p.in[20];
    float S[32];
#pragma unroll
    for (int j = 0; j < 32; ++j) S[j] = S_init ? S_init[(32 * kp + j) * 128 + col] : 0.f;
    __syncthreads();
    for (int t0 = 0; t0 < T; t0 += 32) {
        const int nt = (T - t0) < 32 ? (T - t0) : 32;
        for (int idx = tid; idx < nt * 128; idx += NTHR) { const int t = idx >> 7, c = idx & 127; const size_t o = ((size_t)row0 + t0 + t) * 512 + 128 * h + c;
            sF[idx] = F[o]; sQ[idx] = bf2f(QS[o]); sI[idx] = bf2f(HI[o]); }
        __syncthreads();
        for (int t = 0; t < nt; ++t) {
            const float iv = sI[t * 128 + col]; float o = 0.f;
#pragma unroll
            for (int j4 = 0; j4 < 8; ++j4) {
                const float4 f = *(const float4*)(sF + t * 128 + 32 * kp + 4 * j4), q = *(const float4*)(sQ + t * 128 + 32 * kp + 4 * j4);
                S[4 * j4 + 0] = f.x * S[4 * j4 + 0] + (1.f - f.x) * iv; o += q.x * S[4 * j4 + 0];
                S[4 * j4 + 1] = f.y * S[4 * j4 + 1] + (1.f - f.y) * iv; o += q.y * S[4 * j4 + 1];
                S[4 * j4 + 2] = f.z * S[4 * j4 + 2] + (1.f - f.z) * iv; o += q.z * S[4 * j4 + 2];
                S[4 * j4 + 3] = f.w * S[4 * j4 + 3] + (1.f - f.w) * iv; o += q.w * S[4 * j4 + 3];
            }
            o += dppf<0xB1>(o); o += dppf<0x4E>(o);
            if (kp == 0) sO[t * 128 + col] = o;
        }
        __syncthreads();
        for (int t = wave; t < nt; t += 8) {
            const float o1 = sO[t * 128 + lane], o2 = sO[t * 128 + 64 + lane];
            const float ss = wave_sum(o1 * o1 + o2 * o2);
            const float rstd = rsqrtf(ss * (1.f / 128.f) + 1e-6f);
            const size_t o = ((size_t)row0 + t0 + t) * 512 + 128 * h + lane;
            OB[o] = f2bf(o1 * rstd * norm_g[128 * h + lane] * bf2f(OG[o]));
            OB[o + 64] = f2bf(o2 * rstd * norm_g[128 * h + 64 + lane] * bf2f(OG[o + 64]));
        }
        __syncthreads();
    }
#pragma unroll
    for (int j = 0; j < 32; ++j) S_out[(32 * kp + j) * 128 + col] = S[j];
}

constexpr int HQ_OFF = 0, HK_OFF = 17408, HKH_OFF = 34816, HVT_OFF = 53248, HP_OFF = 71680, HS_OFF = 80896, HD_OFF = 115712, HSEG_OFF = 116224, HSS_OFF = 118272;
__device__ void hgrn_chunk_item(const Params& p, unsigned char* lds, int b, int h) {
    bf16_t* Qt = (bf16_t*)(lds + HQ_OFF);
    bf16_t* Kt = (bf16_t*)(lds + HK_OFF);
    bf16_t* KhT = (bf16_t*)(lds + HKH_OFF);
    bf16_t* VT = (bf16_t*)(lds + HVT_OFF);
    bf16_t* Pm = (bf16_t*)(lds + HP_OFF);
    bf16_t* S0T = (bf16_t*)(lds + HS_OFF);
    float* dk = (float*)(lds + HD_OFF);
    float* segt = (float*)(lds + HSEG_OFF);
    float* ssp = (float*)(lds + HSS_OFF);
    const int tid = tidx(), lane = tid & 63, wave = tid >> 6, li = lane & 15, lq = lane >> 4;
    const float* F = (const float*)(p.ws + WS_F); const bf16_t* QS = (const bf16_t*)(p.ws + WS_QS); const bf16_t* HI = (const bf16_t*)(p.ws + WS_HI);
    const bf16_t* OG = (const bf16_t*)(p.ws + WS_OG); bf16_t* OB = (bf16_t*)(p.ws + WS_OB); const float* norm_g = p.in[20];
    f32x4 Sacc[8];
#pragma unroll
    for (int i = 0; i < 8; ++i) Sacc[i] = (f32x4){0.f, 0.f, 0.f, 0.f};
    __syncthreads();
    for (int i = tid; i < 128 * 136 / 2; i += NTHR) ((unsigned*)S0T)[i] = 0u;
    const int kch = tid & 127, seg = tid >> 7;
    for (int c0 = 0; c0 < SEQ; c0 += 64) {
        const size_t rbase = (size_t)b * SEQ + c0;
        {
            float fv[16], cb[16]; float run = 0.f;
#pragma unroll
            for (int j = 0; j < 16; ++j) { fv[j] = F[(rbase + 16 * seg + j) * 512 + 128 * h + kch]; run += __logf(fv[j]); cb[j] = run; }
            segt[seg * 128 + kch] = run;
            __syncthreads();
            float off = 0.f, tot = 0.f;
#pragma unroll
            for (int s = 0; s < 4; ++s) { const float v = segt[s * 128 + kch]; tot += v; if (s < seg) off += v; }
            const float etot = __expf(tot);
            if (seg == 0) dk[kch] = etot;
            unsigned kh[8];
#pragma unroll
            for (int j = 0; j < 16; j += 2) {
                float kk2[2];
#pragma unroll
                for (int e = 0; e < 2; ++e) {
                    const float bb = off + cb[j + e], eb = __expf(bb), ieb = __builtin_amdgcn_rcpf(eb), kf = 1.f - fv[j + e];
                    const float q = bf2f(QS[(rbase + 16 * seg + j + e) * 512 + 128 * h + kch]);
                    Qt[(16 * seg + j + e) * 136 + kch] = f2bf(q * eb);
                    Kt[(16 * seg + j + e) * 136 + kch] = f2bf(kf * ieb);
                    kk2[e] = kf * ieb * etot;
                }
                kh[j >> 1] = cvt_pk_bf16(kk2[0], kk2[1]);
            }
            *(u32x4*)(KhT + kch * 72 + 16 * seg) = (u32x4){kh[0], kh[1], kh[2], kh[3]};
            *(u32x4*)(KhT + kch * 72 + 16 * seg + 8) = (u32x4){kh[4], kh[5], kh[6], kh[7]};
            unsigned vv[8];
#pragma unroll
            for (int j = 0; j < 16; j += 2) {
                const unsigned lo = HI[(rbase + 16 * seg + j) * 512 + 128 * h + kch], hi = HI[(rbase + 16 * seg + j + 1) * 512 + 128 * h + kch];
                vv[j >> 1] = lo | (hi << 16);
            }
            *(u32x4*)(VT + kch * 72 + 16 * seg) = (u32x4){vv[0], vv[1], vv[2], vv[3]};
            *(u32x4*)(VT + kch * 72 + 16 * seg + 8) = (u32x4){vv[4], vv[5], vv[6], vv[7]};
        }
        __syncthreads();
        {
            const int ti = wave >> 1;
#pragma unroll
            for (int u = 0; u < 2; ++u) {
                const int si = 2 * (wave & 1) + u;
                f32x4 acc = {0.f, 0.f, 0.f, 0.f};
                if (si <= ti) {
#pragma unroll
                    for (int ks = 0; ks < 4; ++ks)
                        acc = mfma16(*(const bf16x8*)(Kt + (16 * si + li) * 136 + 8 * lq + 32 * ks), *(const bf16x8*)(Qt + (16 * ti + li) * 136 + 8 * lq + 32 * ks), acc);
                }
                const int t = 16 * ti + li, s0 = 16 * si + 4 * lq;
                u32x2 w; w.x = cvt_pk_bf16(s0 + 0 <= t ? acc[0] : 0.f, s0 + 1 <= t ? acc[1] : 0.f); w.y = cvt_pk_bf16(s0 + 2 <= t ? acc[2] : 0.f, s0 + 3 <= t ? acc[3] : 0.f);
                *(u32x2*)(Pm + t * 72 + s0) = w;
            }
        }
        __syncthreads();
        {
            const int ti = wave & 3, vh = wave >> 2, t = 16 * ti + li;
            bf16x8 bq[4], bp[2];
#pragma unroll
            for (int ks = 0; ks < 4; ++ks) bq[ks] = *(const bf16x8*)(Qt + t * 136 + 8 * lq + 32 * ks);
#pragma unroll
            for (int ks = 0; ks < 2; ++ks) bp[ks] = *(const bf16x8*)(Pm + t * 72 + 8 * lq + 32 * ks);
            f32x4 o[4]; float ss = 0.f;
#pragma unroll
            for (int vt = 0; vt < 4; ++vt) {
                const int vr = 64 * vh + 16 * vt + li;
                f32x4 acc = {0.f, 0.f, 0.f, 0.f};
#pragma unroll
                for (int ks = 0; ks < 4; ++ks) acc = mfma16(*(const bf16x8*)(S0T + vr * 136 + 8 * lq + 32 * ks), bq[ks], acc);
#pragma unroll
                for (int ks = 0; ks < 2; ++ks) acc = mfma16(*(const bf16x8*)(VT + vr * 72 + 8 * lq + 32 * ks), bp[ks], acc);
                o[vt] = acc; ss += acc[0] * acc[0] + acc[1] * acc[1] + acc[2] * acc[2] + acc[3] * acc[3];
            }
            ss += __shfl_xor(ss, 16); ss += __shfl_xor(ss, 32);
            if (lq == 0) ssp[vh * 64 + t] = ss;
            __syncthreads();
            const float rstd = rsqrtf((ssp[t] + ssp[64 + t]) * (1.f / 128.f) + 1e-6f);
            const size_t orow = (rbase + t) * 512 + 128 * h;
#pragma unroll
            for (int vt = 0; vt < 4; ++vt) {
                const int v = 64 * vh + 16 * vt + 4 * lq;
                const f32x4 g = *(const f32x4*)(norm_g + 128 * h + v);
                const u32x2 og = *(const u32x2*)(OG + orow + v);
                u32x2 w;
                w.x = cvt_pk_bf16(o[vt][0] * rstd * g[0] * __uint_as_float(og.x << 16), o[vt][1] * rstd * g[1] * __uint_as_float(og.x & 0xffff0000u));
                w.y = cvt_pk_bf16(o[vt][2] * rstd * g[2] * __uint_as_float(og.y << 16), o[vt][3] * rstd * g[3] * __uint_as_float(og.y & 0xffff0000u));
                *(u32x2*)(OB + orow + v) = w;
            }
        }
        {
            const f32x4 dv = *(const f32x4*)(dk + 16 * wave + 4 * lq);
            bf16x8 ak[2];
#pragma unroll
            for (int ks = 0; ks < 2; ++ks) ak[ks] = *(const bf16x8*)(KhT + (16 * wave + li) * 72 + 8 * lq + 32 * ks);
#pragma unroll
            for (int vt = 0; vt < 8; ++vt) {
                f32x4 acc = Sacc[vt] * dv;
#pragma unroll
                for (int ks = 0; ks < 2; ++ks) acc = mfma16(ak[ks], *(const bf16x8*)(VT + (16 * vt + li) * 72 + 8 * lq + 32 * ks), acc);
                Sacc[vt] = acc;
                u32x2 w; w.x = cvt_pk_bf16(acc[0], acc[1]); w.y = cvt_pk_bf16(acc[2], acc[3]);
                *(u32x2*)(S0T + (16 * vt + li) * 136 + 16 * wave + 4 * lq) = w;
            }
        }
        __syncthreads();
    }
    float* so = p.out + O_HGP + (size_t)(b * 4 + h) * 16384;
#pragma unroll
    for (int vt = 0; vt < 8; ++vt)
#pragma unroll
        for (int j = 0; j < 4; ++j) so[(16 * wave + 4 * lq + j) * 128 + 16 * vt + li] = Sacc[vt][j];
}


struct Order2 {
    pg8::StaticOrder st; int sub, n, G, c;
    __device__ __forceinline__ void init(int pass, int N, int Gg, int cc) { sub = pass == 0; n = N / 256; G = Gg - 160; c = cc - 160; st.init(TP, N, Gg, cc); }
    __device__ __forceinline__ bool next(int i, Unit& u) const { if (sub) { const int L = i * G + c; if (L >= n) return false; u.pm = 64; u.pn = L; return true; } return st.next(i, u); }
    __device__ __forceinline__ void a_ready(const Unit&) const {}
    __device__ __forceinline__ void done(const Unit&) const {}
};
struct EpiMerge2 {
    static constexpr bool PERM = true, AFTER_DRAIN = false;
    bf16_t* MG; const bf16_t* GATE;
    __device__ __forceinline__ void operator()(AccRef acc, const Unit& u, int wr, int wc, int fr, int fq) const {
        if (u.pm >= 65) { const Unit v{u.pm - 65, u.pn - 4}; const EpiMerge<true> e{MG, GATE}; e(acc, v, wr, wc, fr, fq); }
        else { const EpiMerge<false> e{MG, GATE}; e(acc, u, wr, wc, fr, fq); }
    }
};
struct OrderMerge {
    Order2 o;
    __device__ __forceinline__ bool next(int i, Unit& u) const { if (!o.next(i >> 1, u)) return false; if (i & 1) { u.pm += 65; u.pn += 4; } return true; }
    __device__ __forceinline__ void a_ready(const Unit&) const {}
    __device__ __forceinline__ void done(const Unit&) const {}
};

__device__ __forceinline__ void sub_barrier(unsigned* ctr, unsigned target) {
    __syncthreads();
    if (tidx() == 0) {
        __threadfence();
        __hip_atomic_fetch_add(ctr, 1u, __ATOMIC_RELEASE, __HIP_MEMORY_SCOPE_AGENT);
        while (__hip_atomic_load(ctr, __ATOMIC_ACQUIRE, __HIP_MEMORY_SCOPE_AGENT) < target) __builtin_amdgcn_s_sleep(4);
        __threadfence();
    }
    __syncthreads();
}

__device__ void rwkv_post_pass(const Params& p) {
    const bf16_t* Gg = (const bf16_t*)(p.ws + WS_GG); const float* BONg = (const float*)(p.ws + WS_BON);
    const bf16_t* PR = (const bf16_t*)(p.ws + WS_PR); bf16_t* OA = (bf16_t*)(p.ws + WS_OA);
    const float *mu = p.in[7], *ln_g = p.in[16], *ln_b = p.in[17];
    for (int idx = blockIdx.x * NTHR + tidx(); idx < TP * 64; idx += gridDim.x * NTHR) {
        const int item = idx >> 3, row = item >> 3, h = item & 7, cg = 64 * h + 8 * (idx & 7);
        const u32x4 yw = *(const u32x4*)(OA + (size_t)row * 512 + cg), gw = *(const u32x4*)(Gg + (size_t)row * 512 + cg);
        const bool first = (row & (SEQ - 1)) == 0;
        const u32x4 pcw = *(const u32x4*)(PR + (size_t)row * RP + 1024 + cg), ppw = *(const u32x4*)(PR + (size_t)(row - (first ? 0 : 1)) * RP + 1024 + cg);
        const f32x4 m0 = *(const f32x4*)(mu + 1024 + cg), m1 = *(const f32x4*)(mu + 1024 + cg + 4);
        const f32x4 lg0 = *(const f32x4*)(ln_g + cg), lg1 = *(const f32x4*)(ln_g + cg + 4), lb0 = *(const f32x4*)(ln_b + cg), lb1 = *(const f32x4*)(ln_b + cg + 4);
        const float bon = BONg[(size_t)row * 8 + h];
        f32x4 y0, y1, c0, c1, q0, q1, g0, g1; unpack8(yw, y0, y1); unpack8(pcw, c0, c1); unpack8(ppw, q0, q1); unpack8(gw, g0, g1);
        if (first) { q0 = (f32x4){0.f, 0.f, 0.f, 0.f}; q1 = q0; }
        const f32x4 v0 = c0 + m0 * (q0 - c0), v1 = c1 + m1 * (q1 - c1);
        const float mean = red8((y0[0] + y0[1]) + (y0[2] + y0[3]) + (y1[0] + y1[1]) + (y1[2] + y1[3])) * (1.f / 64.f);
        const f32x4 d0 = y0 - mean, d1 = y1 - mean, dq = d0 * d0 + d1 * d1;
        const float var = red8((dq[0] + dq[1]) + (dq[2] + dq[3])) * (1.f / 64.f);
        const float rs = rsqrtf(var + 64e-5f);
        const f32x4 o0 = (d0 * rs * lg0 + lb0 + bon * v0) * g0, o1 = (d1 * rs * lg1 + lb1 + bon * v1) * g1;
        *(u32x4*)(OA + (size_t)row * 512 + cg) = pack8(o0, o1);
    }
}

__device__ void phase_mix_seq(const Params& p, unsigned char* lds) {
    const int blk = blockIdx.x;
    float* out = p.out;
    if (blk >= 128 && blk < 160) { const int i = blk - 128, b = i >> 2, h = i & 3; hgrn_chunk_item(p, lds, b, h); return; }
    int it, end, step;
    if (blk < 128) { it = blk; end = 128; step = 128; }
    else { it = 128 + blk - 160; end = 128 + 1536; step = gridDim.x - 160; }
#pragma nounroll
    for (; it < end; it += step) {
        if (it < 128 + 1024) {
            int row0, T, half; const float* si; const float* sp; float* so; int h;
            if (it < 128) { const int bh = it >> 1, b = bh >> 3; h = bh & 7; half = it & 1; row0 = b * SEQ; T = SEQ; si = nullptr; sp = nullptr; so = out + O_WKVP + (size_t)(b * 8 + h) * 4096; }
            else { const int j = it - 128, b = j >> 3; h = j & 7; half = -1; row0 = TP + b; T = 1; si = p.in[2] + (size_t)(b * 8 + h) * 4096; sp = p.in[3] + (size_t)b * RP; so = out + O_WKVS + (size_t)(b * 8 + h) * 4096; }
            rwkv_seq_item(p, lds, row0, T, h, si, sp, so, half);
        } else { const int j = it - 128 - 1024, b = j >> 2, h = j & 3;
            hgrn_seq_item(p, lds, TP + b, 1, h, p.in[4] + (size_t)(b * 4 + h) * 16384, out + O_HGS + (size_t)(b * 4 + h) * 16384); }
    }
}

__device__ void phase_final_norm(const Params& p) {
    const int lane = tidx() & 63, wave = tidx() >> 6;
    const float* g = p.in[27];
    float4 gg[4];
#pragma unroll
    for (int i = 0; i < 4; ++i) gg[i] = *(const float4*)(g + i * 256 + lane * 4);
    int row = blockIdx.x * 8 + wave;
    float4 v[4];
    { const int r0 = row < M ? row : M - 1;
#pragma unroll
      for (int i = 0; i < 4; ++i) v[i] = *(const float4*)(p.out + (size_t)r0 * D + i * 256 + lane * 4); }
    for (; row < M; row += gridDim.x * 8) {
        const int rn = row + gridDim.x * 8 < M ? row + gridDim.x * 8 : row;
        float4 nv[4];
#pragma unroll
        for (int i = 0; i < 4; ++i) nv[i] = *(const float4*)(p.out + (size_t)rn * D + i * 256 + lane * 4);
        float ss = 0.f;
#pragma unroll
        for (int i = 0; i < 4; ++i) ss += v[i].x * v[i].x + v[i].y * v[i].y + v[i].z * v[i].z + v[i].w * v[i].w;
        ss = wave_sum(ss);
        const float rstd = rsqrtf(ss * (1.f / D) + 1e-6f);
        float* x = p.out + (size_t)row * D;
#pragma unroll
        for (int i = 0; i < 4; ++i) *(float4*)(x + i * 256 + lane * 4) = make_float4(v[i].x * rstd * gg[i].x, v[i].y * rstd * gg[i].y, v[i].z * rstd * gg[i].z, v[i].w * rstd * gg[i].w);
#pragma unroll
        for (int i = 0; i < 4; ++i) v[i] = nv[i];
    }
}

#ifndef COOP
#define COOP 1
#endif
constexpr int NPHASE = 8;

template <int MASK> __global__ void __launch_bounds__(NTHR) fwd_kernel(Params p_unused) {
    extern __shared__ __attribute__((aligned(16))) unsigned char lds[];
    PG8_LAS unsigned char* l3 = (PG8_LAS unsigned char*)lds;
    const int G = gridDim.x, c = blockIdx.x;
    if (tidx() < 30) ((unsigned long long*)(lds + PARAMS_OFF))[tidx()] = ((const unsigned long long*)__builtin_amdgcn_kernarg_segment_ptr())[tidx()];
    if (tidx() < 8) ((volatile LAS unsigned*)(lds + PARAMS_OFF + 256))[tidx()] = 0u;
    __syncthreads();
#define WS_PTR_() ((unsigned char*)(__attribute__((address_space(1))) unsigned char*)ld_u64_uniform(lds, 29))
    (void)xcd_barrier_post((unsigned*)(WS_PTR_() + WS_XBAR), (volatile LAS unsigned*)(lds + PARAMS_OFF + 256), (unsigned)G);
    if (c >= 160) (void)xcd_barrier_post((unsigned*)(WS_PTR_() + WS_XBAR2), (volatile LAS unsigned*)(lds + PARAMS_OFF + 272), (unsigned)(G - 160));
    if (((const int*)__builtin_amdgcn_kernarg_segment_ptr())[60] == 0x5a17) cg::this_grid().sync();
#define GRID_BARRIER() xcd_barrier_call((unsigned*)(WS_PTR_() + WS_XBAR), xb_xcc_id(), (volatile LAS unsigned*)(lds + PARAMS_OFF + 256), (unsigned)gridDim.x)
#if COOP
#define SEAM(k) do { if ((MASK & (1 << (k))) && (MASK >> ((k) + 1))) GRID_BARRIER(); } while (0)
#else
#define SEAM(k) do { } while (0)
#endif
    if (MASK & 1) { const Params p = load_params(lds); phase_prep(p, lds); } SEAM(0);
    if (MASK & 2) {
        const Params p = load_params(lds); unsigned char* ws = p.ws;
        pg8::Gemm g{(const bf16_t*)(ws + WS_H), (const bf16_t*)(ws + WS_BTIN), MPAD, NIN, D}; pg8::StaticOrder S; S.init(MPAD, NIN, G, c);
        EpiIn E{(bf16_t*)(ws + WS_PR), (bf16_t*)(ws + WS_QS), (float*)(ws + WS_F), (bf16_t*)(ws + WS_HI), (bf16_t*)(ws + WS_OG), (bf16_t*)p.out, (const float*)(ws + WS_MISC), p.out + O_SHP, p.out + O_SHS};
        pg8::gemm_phase<EpiIn, pg8::StaticOrder>(l3, g, S, E);
    } SEAM(1);
    if (MASK & 4) {
        { const Params p = load_params(lds); phase_lora_inputs(p); }
        GRID_BARRIER();
        { const Params p = load_params(lds); unsigned char* ws = p.ws;
          pg8::Gemm g{(const bf16_t*)(ws + WS_LIN), (const bf16_t*)(ws + WS_BTLO), MPAD, 1536, 256}; pg8::StaticOrder S; S.init(MPAD, 1536, G, c);
          EpiLora E{(bf16_t*)(ws + WS_LD), (bf16_t*)(ws + WS_AA), (bf16_t*)(ws + WS_GG), p.in[8], p.in[10]};
          pg8::gemm_phase<EpiLora, pg8::StaticOrder>(l3, g, S, E); }
        GRID_BARRIER();
    }
    if (MASK & 4) { const Params p = load_params(lds); phase_mix_seq(p, lds); }
#pragma nounroll
    for (int pass = (c >= 160 ? 0 : 1); pass < 2; ++pass) {
        unsigned char* ws = (unsigned char*)(__attribute__((address_space(1))) unsigned char*)ld_u64_uniform(lds, 29);
        unsigned* ctr = (unsigned*)(ws + WS_SUBBAR);
        const unsigned nb = (unsigned)(G - 160);
#define SEAM2(k) do { if (pass == 0) xcd_barrier_call((unsigned*)(WS_PTR_() + WS_XBAR2), xb_xcc_id(), (volatile LAS unsigned*)(lds + PARAMS_OFF + 272), (unsigned)(gridDim.x - 160)); else GRID_BARRIER(); } while (0)
        SEAM2(1);
        if (pass == 1) { { const Params p = load_params(lds); rwkv_post_pass(p); } GRID_BARRIER(); }
        {
            const Params p = load_params(lds);
            Order2 S; S.init(pass, D, G, c);
            bf16_t* mg = pass == 0 ? (bf16_t*)(ws + WS_MGS) - (size_t)TP * D : (bf16_t*)(ws + WS_MG);
            { pg8::Gemm g{(const bf16_t*)(ws + WS_OA), (const bf16_t*)(ws + WS_BTUPA), MPAD, D, 512}; OrderMerge SM; SM.o = S; EpiMerge2 E{mg, (const bf16_t*)p.out}; pg8::gemm_phase<EpiMerge2, OrderMerge>(l3, g, SM, E); }
        }
        SEAM2(2);
        {
            const Params p = load_params(lds);
            bf16_t* x1b = pass == 0 ? (bf16_t*)(ws + WS_X1BS) - (size_t)TP * D : (bf16_t*)(ws + WS_X1B);
            const bf16_t* mg = pass == 0 ? (const bf16_t*)(ws + WS_MGS) - (size_t)TP * D : (const bf16_t*)(ws + WS_MG);
            pg8::Gemm g{mg, (const bf16_t*)(ws + WS_BTOUT), MPAD, D, D}; Order2 S; S.init(pass, D, G, c);
            EpiOut E{p.in[0], p.in[1], p.out, x1b, (float*)(ws + WS_MISC + 4096)};
            pg8::gemm_phase<EpiOut, Order2>(l3, g, S, E);
        }
        SEAM2(3);
        {
            bf16_t* x1b = pass == 0 ? (bf16_t*)(ws + WS_X1BS) - (size_t)TP * D : (bf16_t*)(ws + WS_X1B);
            bf16_t* act = pass == 0 ? (bf16_t*)(ws + WS_ACTS) - (size_t)TP * DFF : (bf16_t*)(ws + WS_ACT);
            pg8::Gemm g{x1b, (const bf16_t*)(ws + WS_BTGU), MPAD, 2 * DFF, D}; Order2 S; S.init(pass, 2 * DFF, G, c);
            EpiGU E{act, (const float*)(ws + WS_MISC + 4096)};
            pg8::gemm_phase<EpiGU, Order2>(l3, g, S, E);
        }
        SEAM2(4);
        {
            const Params p = load_params(lds);
            bf16_t* act = pass == 0 ? (bf16_t*)(ws + WS_ACTS) - (size_t)TP * DFF : (bf16_t*)(ws + WS_ACT);
            pg8::Gemm g{act, (const bf16_t*)(ws + WS_BTDN), MPAD, D, DFF}; Order2 S; S.init(pass, D, G, c);
            EpiDown E{p.out};
            pg8::gemm_phase<EpiDown, Order2>(l3, g, S, E);
        }
#undef SEAM2
    }
    GRID_BARRIER();
    if (MASK & 128) { const Params p = load_params(lds); phase_final_norm(p); }
#undef SEAM
}

#if COOP
constexpr int NKERN = 1;
static const void* kern_ptr(int) { return (const void*)fwd_kernel<255>; }
#else
constexpr int NKERN = 8;
static const void* kern_ptr(int k) {
    switch (k) { case 0: return (const void*)fwd_kernel<1>; case 1: return (const void*)fwd_kernel<2>; case 2: return (const void*)fwd_kernel<4>; case 3: return (const void*)fwd_kernel<8>;
                 case 4: return (const void*)fwd_kernel<16>; case 5: return (const void*)fwd_kernel<32>; case 6: return (const void*)fwd_kernel<64>; default: return (const void*)fwd_kernel<128>; }
}
#endif
extern "C" void kernel_launch(void* const* d_in, const int* in_sizes, int n_in, void* d_out, int out_size, void* d_ws, size_t ws_size, hipStream_t stream) {
    static int grid = 0;
    if (grid == 0) {
        if (n_in != 28 || ws_size < WS_END4) { fprintf(stderr, "kernel_launch: unexpected n_in %d / ws_size %zu (need %zu)\n", n_in, ws_size, (size_t)WS_END4); grid = -1; return; }
        for (int k = 0; k < NKERN; ++k) if (hipFuncSetAttribute(kern_ptr(k), hipFuncAttributeMaxDynamicSharedMemorySize, LDS_BYTES) != hipSuccess) { fprintf(stderr, "kernel_launch: hipFuncSetAttribute failed\n"); grid = -1; return; }
        int dev = 0, cus = 0, per_cu = 0;
        (void)hipGetDevice(&dev); (void)hipDeviceGetAttribute(&cus, hipDeviceAttributeMultiprocessorCount, dev);
        (void)hipOccupancyMaxActiveBlocksPerMultiprocessor(&per_cu, kern_ptr(0), NTHR, LDS_BYTES);
        if (per_cu < 1) { fprintf(stderr, "kernel_launch: occupancy query says %d blocks per CU\n", per_cu); per_cu = 1; }
        grid = cus;
        (void)hipGetLastError();
    }
    if (grid < 0) return;
    (void)hipMemsetAsync((unsigned char*)d_ws + WS_XBAR, 0, (size_t)(WS_XBAR2 - WS_XBAR) + (size_t)XCD_BAR_WORDS * 4, stream);
    Params p{};
    for (int i = 0; i < 28; ++i) p.in[i] = (const float*)d_in[i];
    p.out = (float*)d_out; p.ws = (unsigned char*)d_ws;
#if COOP
    void* args[] = {&p};
    hipError_t e = hipLaunchCooperativeKernel(kern_ptr(0), dim3(grid), dim3(NTHR), args, LDS_BYTES, stream);
    if (e != hipSuccess) fprintf(stderr, "cooperative launch failed: %s (grid %d)\n", hipGetErrorString(e), grid);
#else
    for (int ph = 0; ph < NPHASE; ++ph) { void* args[] = {&p}; (void)hipLaunchKernel(kern_ptr(ph), dim3(grid), dim3(NTHR), args, LDS_BYTES, stream); }
#endif
}
```

```cpp
#include <hip/hip_runtime.h>
#include <hip/hip_cooperative_groups.h>
#include <cstdio>
namespace cg = cooperative_groups;
__device__ __forceinline__ int tidx() { int t = __builtin_amdgcn_workitem_id_x(); asm volatile("" : "+v"(t)); return t; }
namespace pg8 {
#define PG8_LAS __attribute__((address_space(3)))
typedef unsigned short bf16_t;
typedef short bf16x8 __attribute__((ext_vector_type(8)));
typedef float f32x4 __attribute__((ext_vector_type(4)));
typedef unsigned u32x4 __attribute__((ext_vector_type(4)));
constexpr int BM = 256, BK = 64, HALF = 128, HTB = HALF * BK * 2  , STAGE_BYTES = 8 * HTB, NXCD = 8, WGM = 8;

__host__ __device__ __forceinline__ int lds_byte(int r, int c) { const int st = (r >> 4) * 2 + (c >> 5), rr = r & 15, cc = c & 31, ob = rr * 64 + cc * 2; return st * 1024 + (ob ^ (((ob >> 9) & 1) << 5)); }
__host__ __device__ __forceinline__ void stage_rc(int b, int& R, int& C) { const int st = b / 1024, sb = b % 1024, swz = sb ^ (((sb >> 9) & 1) << 5); R = (st >> 1) * 16 + swz / 64; C = (st & 1) * 32 + (swz % 64) / 2; }
__host__ __device__ __forceinline__ int perm32(int rho) { const int n = rho >> 4, i = rho & 15; return 8 * (i >> 2) + 4 * n + (i & 3); }

struct Unit { int pm, pn; };
struct Gemm { const bf16_t* A; const bf16_t* Bt; int M, N, K; };

struct StaticOrder {
    int nM, nN, nwg, G, c;
    __host__ __device__ void init(int M, int N, int G_, int c_) { nM = M / BM; nN = N / BM; nwg = nM * nN; G = G_; c = c_; }
    __host__ __device__ bool next(int i, Unit& u) const {
        const long L = (long)i * G + c; if (L >= nwg) return false;
        int wgid = (int)L; { const int q = nwg / NXCD, r = nwg % NXCD, xcd = wgid % NXCD, off = wgid / NXCD; wgid = (xcd < r ? xcd * (q + 1) : r * (q + 1) + (xcd - r) * q) + off; }
        const int nig = WGM * nN, gid = wgid / nig, fm = gid * WGM, gsz = (nM - fm) < WGM ? (nM - fm) : WGM;
        u.pm = fm + ((wgid % nig) % gsz); u.pn = (wgid % nig) / gsz; return true;
    }
    __device__ __forceinline__ void a_ready(const Unit&) const {}
    __device__ __forceinline__ void done(const Unit&) const {}
};
typedef float f32x2 __attribute__((ext_vector_type(2)));
typedef __bf16 bf16x2n __attribute__((ext_vector_type(2)));
__device__ __forceinline__ unsigned cvt_pk_bf16(float lo, float hi) { const f32x2 v = {lo, hi}; return __builtin_bit_cast(unsigned, __builtin_convertvector(v, bf16x2n)); }
template <class Epi, class Sched>
__device__ __forceinline__ void gemm_phase(PG8_LAS unsigned char* lds, const Gemm g, const Sched& S, const Epi& E) {
    const int tid = tidx(), wid = __builtin_amdgcn_readfirstlane(tid >> 6), lane = tid & 63, wr = wid >> 2, wc = wid & 3, fr = lane & 15, fq = lane >> 4;
    const int K = g.K, nt = K / BK;
    unsigned voffA[2], voffB[2];
#pragma unroll
    for (int i = 0; i < 2; ++i) { int R, C; stage_rc(tid * 16 + i * 8192, R, C); const int Rb = Epi::PERM ? ((R & ~31) + perm32(R & 31)) : R;
        voffA[i] = (unsigned)(R * K + C) * 2u; voffB[i] = (unsigned)(Rb * K + C) * 2u; }
    const size_t kstep = (size_t)(BK * 2);
    const size_t hstep = (size_t)HALF * K * 2;
    const size_t tstep = 2 * hstep;
    const unsigned ldsw = (unsigned)wid * 1024u;
    const int aoff = lds_byte(wr * 64 + fr, fq * 8), boff = lds_byte(wc * 32 + fr, fq * 8);
#define PG8_SA(b, h) (((b) * 2 + (h)) * HTB)
#define PG8_SB(b, h) ((4 + (b) * 2 + (h)) * HTB)
#define PG8_STAGE(bufoff, gbase, voff) do { _Pragma("unroll") for (int _i = 0; _i < 2; ++_i) \
        __builtin_amdgcn_global_load_lds((const unsigned*)((const char*)(gbase) + (voff)[_i]), (PG8_LAS unsigned*)(lds + (bufoff) + ldsw + _i * 8192), 16, 0, 0); } while (0)
#define PG8_LDA(dst, b, h) do { _Pragma("unroll") for (int m = 0; m < 4; ++m) _Pragma("unroll") for (int k = 0; k < 2; ++k) dst[m][k] = *(const PG8_LAS bf16x8*)(lds + PG8_SA(b, h) + aoff + m * 2048 + k * 1024); } while (0)
#define PG8_LDB(dst, b, h) do { _Pragma("unroll") for (int n = 0; n < 2; ++n) _Pragma("unroll") for (int k = 0; k < 2; ++k) dst[n][k] = *(const PG8_LAS bf16x8*)(lds + PG8_SB(b, h) + boff + n * 2048 + k * 1024); } while (0)
#define PG8_MMA(ai, bj, At, Bt) do { __builtin_amdgcn_s_setprio(1); _Pragma("unroll") for (int m = 0; m < 4; ++m) _Pragma("unroll") for (int n = 0; n < 2; ++n) _Pragma("unroll") for (int k = 0; k < 2; ++k) \
        acc[ai][bj][m][n] = __builtin_amdgcn_mfma_f32_16x16x32_bf16(Bt[n][k], At[m][k], acc[ai][bj][m][n], 0, 0, 0); __builtin_amdgcn_s_setprio(0); } while (0)
#define PG8_WAIT_V(n) asm volatile("s_waitcnt vmcnt(" #n ")" ::: "memory")
#define PG8_WAIT_L(n) asm volatile("s_waitcnt lgkmcnt(" #n ")" ::: "memory")
#define PG8_BAR __builtin_amdgcn_s_barrier()
#define PG8_SCHED __builtin_amdgcn_sched_barrier(0)
    Unit cur, nxt; int ui = 0;
    if (!S.next(0, cur)) return;
    f32x4 acc[2][2][4][2];
#pragma unroll
    for (int a = 0; a < 2; ++a)
#pragma unroll
        for (int b = 0; b < 2; ++b)
#pragma unroll
            for (int m = 0; m < 4; ++m)
#pragma unroll
                for (int n = 0; n < 2; ++n) acc[a][b][m][n] = (f32x4){0.f, 0.f, 0.f, 0.f};
    bf16x8 At[4][2], B0[2][2], B1[2][2];
    const char* cA = (const char*)g.A + (size_t)cur.pm * tstep; const char* cB = (const char*)g.Bt + (size_t)cur.pn * tstep;
    S.a_ready(cur);
    PG8_STAGE(PG8_SB(0, 0), cB, voffB); PG8_STAGE(PG8_SA(0, 0), cA, voffA); PG8_STAGE(PG8_SB(0, 1), cB + hstep, voffB); PG8_STAGE(PG8_SA(0, 1), cA + hstep, voffA);
    if (wr == 1) PG8_BAR;
    PG8_WAIT_V(4); PG8_BAR;
    PG8_STAGE(PG8_SB(1, 0), cB + kstep, voffB); PG8_STAGE(PG8_SA(1, 0), cA + kstep, voffA); PG8_STAGE(PG8_SB(1, 1), cB + hstep + kstep, voffB);
    PG8_WAIT_V(6); PG8_BAR;
    for (;;) {
        const bool has_next = S.next(ui + 1, nxt);
        const char* nA = has_next ? (const char*)g.A + (size_t)nxt.pm * tstep : cA; const char* nB = has_next ? (const char*)g.Bt + (size_t)nxt.pn * tstep : cB;
        for (int t = 0; t < nt; t += 2) {
            const bool last = (t == nt - 2);
            const char* a1 = cA + (size_t)(t + 1) * kstep;
            const char* a2 = last ? nA : cA + (size_t)(t + 2) * kstep; const char* b2 = last ? nB : cB + (size_t)(t + 2) * kstep;
            const char* a3 = a2 + kstep; const char* b3 = b2 + kstep;
            if (last && has_next) S.a_ready(nxt);
            PG8_LDB(B0, 0, 0); PG8_SCHED; PG8_LDA(At, 0, 0); PG8_STAGE(PG8_SA(1, 1), a1 + hstep, voffA);
            PG8_WAIT_L(8); PG8_BAR; PG8_WAIT_L(0); PG8_MMA(0, 0, At, B0); PG8_BAR; PG8_SCHED;
            PG8_LDB(B1, 0, 1); PG8_STAGE(PG8_SB(0, 0), b2, voffB);
            PG8_BAR; PG8_WAIT_L(0); PG8_MMA(0, 1, At, B1); PG8_BAR;
            PG8_LDA(At, 0, 1); PG8_STAGE(PG8_SA(0, 0), a2, voffA);
            PG8_BAR; PG8_WAIT_L(0); PG8_MMA(1, 0, At, B0); PG8_BAR; PG8_SCHED;
            PG8_STAGE(PG8_SB(0, 1), b2 + hstep, voffB);
            PG8_WAIT_V(6); PG8_BAR; PG8_MMA(1, 1, At, B1); PG8_BAR;
            PG8_LDB(B0, 1, 0); PG8_SCHED; PG8_LDA(At, 1, 0); PG8_STAGE(PG8_SA(0, 1), a2 + hstep, voffA);
            PG8_WAIT_L(8); PG8_BAR; PG8_WAIT_L(0); PG8_MMA(0, 0, At, B0); PG8_BAR; PG8_SCHED;
            PG8_LDB(B1, 1, 1); PG8_STAGE(PG8_SB(1, 0), b3, voffB);
            PG8_BAR; PG8_WAIT_L(0); PG8_MMA(0, 1, At, B1); PG8_BAR;
            PG8_LDA(At, 1, 1); PG8_STAGE(PG8_SA(1, 0), a3, voffA);
            PG8_BAR; PG8_WAIT_L(0); PG8_MMA(1, 0, At, B0); PG8_BAR; PG8_SCHED;
            PG8_STAGE(PG8_SB(1, 1), b3 + hstep, voffB);
            PG8_WAIT_V(6); PG8_BAR; PG8_MMA(1, 1, At, B1); PG8_BAR;
        }
        if constexpr (!Epi::AFTER_DRAIN) { E(acc, cur, wr, wc, fr, fq); S.done(cur); }
        if (!has_next) break;
#pragma unroll
        for (int a = 0; a < 2; ++a)
#pragma unroll
            for (int b = 0; b < 2; ++b)
#pragma unroll
                for (int m = 0; m < 4; ++m)
#pragma unroll
                    for (int n = 0; n < 2; ++n) acc[a][b][m][n] = (f32x4){0.f, 0.f, 0.f, 0.f};
        cur = nxt; cA = nA; cB = nB; ++ui;
    }
    PG8_WAIT_V(0);
    if (wr == 0) PG8_BAR;
    PG8_BAR;
    if constexpr (Epi::AFTER_DRAIN) { E.fused(acc, cur, wr, wc, fr, fq, lds, wid, lane); S.done(cur); }
#undef PG8_SA
#undef PG8_SB
#undef PG8_STAGE
#undef PG8_LDA
#undef PG8_LDB
#undef PG8_MMA
#undef PG8_WAIT_V
#undef PG8_WAIT_L
#undef PG8_BAR
#undef PG8_SCHED
}
}


using pg8::bf16_t; using pg8::bf16x8; using pg8::f32x4; using pg8::u32x4; using pg8::Unit; using pg8::cvt_pk_bf16;
typedef unsigned u32x2 __attribute__((ext_vector_type(2)));

constexpr int D = 1024, TP = 16384, TSMP = 128, M = TP + TSMP, MPAD = 16640, SEQ = 2048;
constexpr int RP = 1792, NIN = 5888, DFF = 2816;
constexpr int NTHR = 512;
constexpr int LDS_BYTES = 140 * 1024;

constexpr size_t O_Y = 0, O_WKVP = (size_t)M * D, O_SHP = O_WKVP + 8 * 8 * 64 * 64, O_HGP = O_SHP + 8 * RP,
                 O_WKVS = O_HGP + 8 * 4 * 128 * 128, O_SHS = O_WKVS + (size_t)128 * 8 * 64 * 64, O_HGS = O_SHS + 128 * RP;
constexpr size_t WS_BTIN = 0, WS_BTUPA = WS_BTIN + (size_t)NIN * D * 2, WS_BTUPB = WS_BTUPA + (size_t)D * 512 * 2, WS_BTOUT = WS_BTUPB + (size_t)D * 512 * 2,
                 WS_BTGU = WS_BTOUT + (size_t)D * D * 2, WS_BTDN = WS_BTGU + (size_t)2 * DFF * D * 2, WS_MISC = WS_BTDN + (size_t)D * DFF * 2,
                 WS_H = WS_MISC + 262144, WS_PR = WS_H + (size_t)MPAD * D * 2, WS_QS = WS_PR + (size_t)MPAD * RP * 2, WS_F = WS_QS + (size_t)MPAD * 512 * 2,
                 WS_HI = WS_F + (size_t)MPAD * 512 * 4, WS_OG = WS_HI + (size_t)MPAD * 512 * 2, WS_OA = WS_OG + (size_t)MPAD * 512 * 2,
                 WS_OB = WS_OA + (size_t)MPAD * 512 * 2, WS_END = WS_OB + (size_t)MPAD * 512 * 2;
constexpr size_t WS_MG = WS_H, WS_ACT = WS_PR, WS_X1B = WS_OA;
constexpr size_t WS_ACTS = WS_END, WS_X1BS = WS_ACTS + (size_t)256 * DFF * 2, WS_END2 = WS_X1BS + (size_t)256 * D * 2;
constexpr size_t WS_SUBBAR = WS_MISC + 196608;
constexpr size_t WS_XBAR2 = WS_MISC + 229376;
constexpr size_t WS_XBAR = WS_MISC + 212992;
constexpr size_t WS_LIN = WS_OA;
constexpr size_t WS_LD = WS_H, WS_AA = WS_H + (size_t)MPAD * 512 * 2;
constexpr size_t WS_GG = WS_END2, WS_MGS = WS_GG + (size_t)MPAD * 512 * 2, WS_BTLO = WS_MGS + (size_t)256 * D * 2, WS_END3 = WS_BTLO + (size_t)1536 * 256 * 2;
constexpr size_t WS_BON = WS_END3, WS_END4 = WS_BON + (size_t)TP * 8 * 4;
static_assert(WS_END4 <= (size_t)256 * 1024 * 1024, "workspace 4");
static_assert((size_t)MPAD * DFF * 2 <= WS_OA - WS_PR, "ACT alias");
static_assert(WS_END2 <= (size_t)256 * 1024 * 1024, "workspace");

struct Params {
    const float* in[28];
    float* out;
    unsigned char* ws;
    int pad0, pad1;
};


#define XB_TMO      128
#define XB_XCNT(j)  (256  + 64 * (j))
#define XB_XSUB(j)  (1280 + 64 * (j))
#define XB_XGEN(j)  (2304 + 64 * (j))
#define XB_TOP      3328
#define XB_TOPGEN   3392
#define XCD_BAR_WORDS 3456
#define XB_SPIN_CAP (1u << 18)
#ifndef LAS
#define LAS __attribute__((address_space(3)))
#endif

__device__ __forceinline__ unsigned xb_ld(unsigned* p)              { return __hip_atomic_load(p, __ATOMIC_RELAXED, __HIP_MEMORY_SCOPE_AGENT); }
__device__ __forceinline__ unsigned xb_add(unsigned* p, unsigned v) { return __hip_atomic_fetch_add(p, v, __ATOMIC_RELAXED, __HIP_MEMORY_SCOPE_AGENT); }
__device__ __forceinline__ unsigned xb_xcc_id() { return (unsigned)__builtin_amdgcn_s_getreg((3 << 11) | 20) & 0xFu; }
#define XB_SPIN(cond, bar) do { unsigned _sp = 0; while (cond) { __builtin_amdgcn_s_sleep(1); \
    if ((++_sp & 255u) == 0u) { if (xb_ld(&(bar)[XB_TMO])) break; if (_sp > XB_SPIN_CAP) { atomicAdd(&(bar)[XB_TMO], 1u); break; } } } } while (0)

struct XcdBarrier {
    unsigned nexp;
    unsigned* bar; unsigned x;
    volatile LAS unsigned* st;
};

__device__ __forceinline__ XcdBarrier xcd_barrier_post(unsigned* bar, volatile LAS unsigned* st, unsigned nexp) {
    XcdBarrier b; b.nexp = nexp; b.bar = bar; b.x = xb_xcc_id(); b.st = st;
    if (threadIdx.x == 0) (void)xb_add(&bar[XB_XCNT(b.x)], 1u);
    return b;
}
__device__ __forceinline__ void xcd_barrier_complete(unsigned* bar, unsigned x, unsigned& nloc, unsigned& nx, unsigned G) {
    unsigned sum, cnt, mine, sp = 0u;
    for (;;) {
        sum = 0u; cnt = 0u; mine = 0u;
#pragma unroll
        for (unsigned j = 0; j < 16; ++j) { const unsigned c = xb_ld(&bar[XB_XCNT(j)]); sum += c; cnt += (c > 0u) ? 1u : 0u; mine = (j == x) ? c : mine; }
        if (sum == G) break;
        __builtin_amdgcn_s_sleep(1);
        if ((++sp & 255u) == 0u) { if (xb_ld(&bar[XB_TMO])) break; if (sp > XB_SPIN_CAP) { atomicAdd(&bar[XB_TMO], 1u); break; } }
    }
    nloc = mine > 0u ? mine : 1u; nx = cnt > 0u ? cnt : 1u;
}

__device__ __forceinline__ void xcd_barrier(const XcdBarrier& b) {
    asm volatile("s_waitcnt vmcnt(0)" ::: "memory");
    __syncthreads();
    if (threadIdx.x == 0) {
        unsigned* bar = b.bar;
        __builtin_amdgcn_s_waitcnt(0);
        unsigned nloc = b.st[0], nx = b.st[1];
        if (nloc == 0u) { xcd_barrier_complete(bar, b.x, nloc, nx, b.nexp); b.st[0] = nloc; b.st[1] = nx; }
        const unsigned old = xb_add(&bar[XB_XSUB(b.x)], 1u);
        const unsigned gen = old / nloc;
        if (old + 1u == (gen + 1u) * nloc) {
            __builtin_amdgcn_fence(__ATOMIC_RELEASE, "agent");
            asm volatile("s_waitcnt vmcnt(0)" ::: "memory");
            const unsigned og = xb_add(&bar[XB_TOP], 1u);
            const unsigned tg = og / nx;
            if (og + 1u == (tg + 1u) * nx) xb_add(&bar[XB_TOPGEN], 1u);
            else XB_SPIN(xb_ld(&bar[XB_TOPGEN]) == tg, bar);
            __builtin_amdgcn_fence(__ATOMIC_ACQUIRE, "agent");
            xb_add(&bar[XB_XGEN(b.x)], 1u);
            asm volatile("s_waitcnt vmcnt(0)" ::: "memory");
        } else {
            XB_SPIN(xb_ld(&bar[XB_XGEN(b.x)]) == gen, bar);
            __builtin_amdgcn_fence(__ATOMIC_ACQUIRE, "agent");
            asm volatile("s_waitcnt vmcnt(0)" ::: "memory");
        }
    }
    __syncthreads();
}


__device__ __attribute__((noinline)) void xcd_barrier_call(unsigned* bar, unsigned x, volatile LAS unsigned* st, unsigned nexp) { XcdBarrier b; b.nexp = nexp; b.bar = bar; b.x = x; b.st = st; xcd_barrier(b); }

constexpr int PARAMS_OFF = LDS_BYTES - 512;
__device__ __forceinline__ unsigned long long ld_u64_uniform(const unsigned char* lds, int i) {
    const unsigned long long v = ((const unsigned long long*)(lds + PARAMS_OFF))[i];
    const unsigned lo = __builtin_amdgcn_readfirstlane((unsigned)v), hi = __builtin_amdgcn_readfirstlane((unsigned)(v >> 32));
    return ((unsigned long long)hi << 32) | lo;
}
__device__ __forceinline__ Params load_params(const unsigned char* lds) {
    Params q;
#pragma unroll
    for (int i = 0; i < 28; ++i) q.in[i] = (const float*)(const __attribute__((address_space(1))) float*)ld_u64_uniform(lds, i);
    q.out = (float*)(__attribute__((address_space(1))) float*)ld_u64_uniform(lds, 28); q.ws = (unsigned char*)(__attribute__((address_space(1))) unsigned char*)ld_u64_uniform(lds, 29); q.pad0 = 0; q.pad1 = 0;
    return q;
}

__device__ __forceinline__ float sigmoidf_(float x) { return __builtin_amdgcn_rcpf(1.f + __expf(-x)); }
__device__ __forceinline__ float bf2f(bf16_t v) { return __uint_as_float(((unsigned)v) << 16); }
__device__ __forceinline__ bf16_t f2bf(float f) { unsigned u = __float_as_uint(f); u += 0x7FFFu + ((u >> 16) & 1u); return (bf16_t)(u >> 16); }
template <int CTRL> __device__ __forceinline__ float dppf(float v) { return __builtin_bit_cast(float, __builtin_amdgcn_update_dpp(0, __builtin_bit_cast(int, v), CTRL, 0xF, 0xF, true)); }
__device__ __forceinline__ float red8(float v) { v += dppf<0xB1>(v); v += dppf<0x4E>(v); v += dppf<0x141>(v); return v; }
__device__ __forceinline__ float red16(float v) { v = red8(v); v += dppf<0x140>(v); return v; }
__device__ __forceinline__ float rdl(float v, int l) { return __builtin_bit_cast(float, __builtin_amdgcn_readlane(__builtin_bit_cast(int, v), l)); }
__device__ __forceinline__ float wave_sum(float v) { v = red16(v); return (rdl(v, 0) + rdl(v, 16)) + (rdl(v, 32) + rdl(v, 48)); }
__device__ __forceinline__ float fast_tanh(float x) { return 1.f - 2.f * __builtin_amdgcn_rcpf(1.f + __expf(2.f * x)); }
typedef float f2 __attribute__((ext_vector_type(2)));

struct TileDesc { const float* src; const float* kscale; bf16_t* dst; int K, N, kt, nt, mode; };
__device__ __forceinline__ TileDesc tile_desc(const Params& p, int t) {
    unsigned char* ws = p.ws; TileDesc d; d.kscale = nullptr; d.mode = 0;
    if (t < 1472) { d.src = p.in[6]; d.K = D; d.N = NIN; d.kt = t / 92; d.nt = t % 92; d.dst = (bf16_t*)(ws + WS_BTIN); }
    else if (t < 1600) { const int u = t - 1472; d.src = p.in[18]; d.K = 512; d.N = D; d.kt = u / 16; d.nt = u % 16; d.dst = (bf16_t*)(ws + WS_BTUPA); }
    else if (t < 1728) { const int u = t - 1600; d.src = p.in[21]; d.K = 512; d.N = D; d.kt = u / 16; d.nt = u % 16; d.dst = (bf16_t*)(ws + WS_BTUPB); }
    else if (t < 1984) { const int u = t - 1728; d.src = p.in[22]; d.K = D; d.N = D; d.kt = u / 16; d.nt = u % 16; d.dst = (bf16_t*)(ws + WS_BTOUT); }
    else if (t < 2688) { const int u = t - 1984; d.src = p.in[24]; d.K = D; d.N = DFF; d.kt = u / 44; d.nt = u % 44; d.dst = (bf16_t*)(ws + WS_BTGU); d.mode = 1; d.kscale = p.in[23]; }
    else if (t < 3392) { const int u = t - 2688; d.src = p.in[25]; d.K = D; d.N = DFF; d.kt = u / 44; d.nt = u % 44; d.dst = (bf16_t*)(ws + WS_BTGU); d.mode = 2; d.kscale = p.in[23]; }
    else { const int u = t - 3392; d.src = p.in[26]; d.K = DFF; d.N = D; d.kt = u / 16; d.nt = u % 16; d.dst = (bf16_t*)(ws + WS_BTDN); }
    return d;
}
__device__ void phase_prep(const Params& p, unsigned char* lds) {
    float* tile = (float*)lds;
    unsigned char* ws = p.ws;
    {
        const int tid = tidx(), li = tid >> 3, j0 = (tid & 7) * 8;
        int t = blockIdx.x;
        TileDesc d = tile_desc(p, t < 4096 ? t : 4095);
        const float* s0 = d.src + (size_t)(d.kt * 64 + li) * d.N + d.nt * 64 + j0;
        float4 a = *(const float4*)s0, b = *(const float4*)(s0 + 4);
        float sc = d.kscale ? d.kscale[d.kt * 64 + li] : 1.f;
        for (; t < 4096; t += gridDim.x) {
            const int tn = t + gridDim.x < 4096 ? t + gridDim.x : t;
            const TileDesc dn = tile_desc(p, tn);
            const float* sn = dn.src + (size_t)(dn.kt * 64 + li) * dn.N + dn.nt * 64 + j0;
            const float4 na = *(const float4*)sn, nb = *(const float4*)(sn + 4);
            const float nsc = dn.kscale ? dn.kscale[dn.kt * 64 + li] : 1.f;
            float* tw = tile + li * 65 + j0;
            tw[0] = a.x * sc; tw[1] = a.y * sc; tw[2] = a.z * sc; tw[3] = a.w * sc; tw[4] = b.x * sc; tw[5] = b.y * sc; tw[6] = b.z * sc; tw[7] = b.w * sc;
            asm volatile("s_waitcnt lgkmcnt(0)" ::: "memory"); __builtin_amdgcn_s_barrier(); asm volatile("" ::: "memory");
            {
                const int n = tid >> 3, k0 = (tid & 7) * 8;
                float v[8];
#pragma unroll
                for (int kk = 0; kk < 8; ++kk) v[kk] = tile[(k0 + kk) * 65 + n];
                u32x4 w; w.x = cvt_pk_bf16(v[0], v[1]); w.y = cvt_pk_bf16(v[2], v[3]); w.z = cvt_pk_bf16(v[4], v[5]); w.w = cvt_pk_bf16(v[6], v[7]);
                const int ncol = d.nt * 64 + n;
                const int drow = d.mode == 0 ? ncol : ((ncol >> 7) * 256 + (d.mode == 2 ? 128 : 0) + (ncol & 127));
                *(u32x4*)(d.dst + (size_t)drow * d.K + d.kt * 64 + k0) = w;
            }
            asm volatile("s_waitcnt lgkmcnt(0)" ::: "memory"); __builtin_amdgcn_s_barrier(); asm volatile("" ::: "memory");
            d = dn; a = na; b = nb; sc = nsc;
        }
    }
    const int lane = tidx() & 63, wave = tidx() >> 6;
    const float* g = p.in[5];
    bf16_t* H = (bf16_t*)(ws + WS_H);
    {
        float4 gg[4];
#pragma unroll
        for (int i = 0; i < 4; ++i) gg[i] = *(const float4*)(g + i * 256 + lane * 4);
        int row = blockIdx.x * 8 + wave;
        float4 v[4];
        { const int r0 = row < M ? row : M - 1; const float* x = r0 < TP ? p.in[0] + (size_t)r0 * D : p.in[1] + (size_t)(r0 - TP) * D;
#pragma unroll
          for (int i = 0; i < 4; ++i) v[i] = *(const float4*)(x + i * 256 + lane * 4); }
        for (; row < M; row += gridDim.x * 8) {
            const int rn = row + gridDim.x * 8 < M ? row + gridDim.x * 8 : row;
            const float* xn = rn < TP ? p.in[0] + (size_t)rn * D : p.in[1] + (size_t)(rn - TP) * D;
            float4 nv[4];
#pragma unroll
            for (int i = 0; i < 4; ++i) nv[i] = *(const float4*)(xn + i * 256 + lane * 4);
            float ss = 0.f;
#pragma unroll
            for (int i = 0; i < 4; ++i) ss += v[i].x * v[i].x + v[i].y * v[i].y + v[i].z * v[i].z + v[i].w * v[i].w;
            ss = wave_sum(ss);
            const float rstd = rsqrtf(ss * (1.f / D) + 1e-6f);
#pragma unroll
            for (int i = 0; i < 4; ++i) { u32x2 w; w.x = cvt_pk_bf16(v[i].x * rstd * gg[i].x, v[i].y * rstd * gg[i].y); w.y = cvt_pk_bf16(v[i].z * rstd * gg[i].z, v[i].w * rstd * gg[i].w);
                *(u32x2*)(H + (size_t)row * D + i * 256 + lane * 4) = w; }
#pragma unroll
            for (int i = 0; i < 4; ++i) v[i] = nv[i];
        }
    }
    float* lb = (float*)(ws + WS_MISC); float* ssq = (float*)(ws + WS_MISC + 4096);
    const int gt = blockIdx.x * NTHR + tidx();
    if (gt < 512) lb[gt] = 1.f / (1.f + __expf(p.in[19][512 + gt] - p.in[19][gt]));
    for (int i = gt; i < MPAD; i += gridDim.x * NTHR) ssq[i] = 0.f;
    if (gt == 0) *(unsigned*)(ws + WS_SUBBAR) = 0u;
    {
        bf16_t* bl = (bf16_t*)(ws + WS_BTLO);
        for (int i = gt; i < 1536 * 256; i += gridDim.x * NTHR) {
            const int n = i >> 8, k = i & 255; float v = 0.f;
            if (n < 512) { if (k < 64) v = p.in[9][k * 512 + n]; }
            else if (n < 1024) { if (k >= 64 && k < 128) v = p.in[11][(k - 64) * 512 + (n - 512)]; }
            else { if (k >= 128) v = p.in[12][(k - 128) * 512 + (n - 1024)]; }
            bl[i] = f2bf(v);
        }
    }
}

typedef const f32x4 (&AccRef)[2][2][4][2];
__device__ __forceinline__ u32x4 pack8(const f32x4 a, const f32x4 b) { u32x4 w; w.x = cvt_pk_bf16(a[0], a[1]); w.y = cvt_pk_bf16(a[2], a[3]); w.z = cvt_pk_bf16(b[0], b[1]); w.w = cvt_pk_bf16(b[2], b[3]); return w; }
__device__ __forceinline__ void unpack8(const u32x4 w, f32x4& a, f32x4& b) {
    a[0] = __uint_as_float(w.x << 16); a[1] = __uint_as_float(w.x & 0xffff0000u); a[2] = __uint_as_float(w.y << 16); a[3] = __uint_as_float(w.y & 0xffff0000u);
    b[0] = __uint_as_float(w.z << 16); b[1] = __uint_as_float(w.z & 0xffff0000u); b[2] = __uint_as_float(w.w << 16); b[3] = __uint_as_float(w.w & 0xffff0000u); }

struct EpiIn {
    static constexpr bool PERM = true, AFTER_DRAIN = false;
    bf16_t* PR; bf16_t* QS; float* F; bf16_t* HI; bf16_t* OG; bf16_t* GATE; const float* lb; float* shp; float* shs;
    __device__ __forceinline__ void operator()(AccRef acc, const Unit& u, int wr, int wc, int fr, int fq) const {
        const int row0 = u.pm * 256 + wr * 64 + fr, cl = wc * 32 + 8 * fq;
        const int pn = u.pn;
#pragma unroll
        for (int ai = 0; ai < 2; ++ai)
#pragma unroll
            for (int m = 0; m < 4; ++m) {
                const int row = row0 + ai * 128 + m * 16;
#pragma unroll
                for (int bj = 0; bj < 2; ++bj) {
                    f32x4 v0 = acc[ai][bj][m][0], v1 = acc[ai][bj][m][1];
                    const int col = pn * 256 + bj * 128 + cl;
                    if (pn < 7) {
                        *(u32x4*)(PR + (size_t)row * RP + col) = pack8(v0, v1);
                        float* sp = nullptr;
                        if (row < TP) { if ((row & (SEQ - 1)) == SEQ - 1) sp = shp + (size_t)(row >> 11) * RP + col; }
                        else if (row < M) sp = shs + (size_t)(row - TP) * RP + col;
                        if (sp) { *(f32x4*)sp = v0; *(f32x4*)(sp + 4) = v1; }
                    } else if (pn < 15) {
                        const int hc = col - RP, ty = (pn - 7) >> 1, cc = hc - ty * 512;
                        if (ty == 0) {
#pragma unroll
                            for (int j = 0; j < 4; ++j) { v0[j] = v0[j] * sigmoidf_(v0[j]); v1[j] = v1[j] * sigmoidf_(v1[j]); }
                            *(u32x4*)(QS + (size_t)row * 512 + cc) = pack8(v0, v1);
                        } else if (ty == 1) {
                            const f32x4 l0 = *(const f32x4*)(lb + cc), l1 = *(const f32x4*)(lb + cc + 4);
#pragma unroll
                            for (int j = 0; j < 4; ++j) { v0[j] = l0[j] + (1.f - l0[j]) * sigmoidf_(v0[j]); v1[j] = l1[j] + (1.f - l1[j]) * sigmoidf_(v1[j]); }
                            *(f32x4*)(F + (size_t)row * 512 + cc) = v0; *(f32x4*)(F + (size_t)row * 512 + cc + 4) = v1;
                        } else if (ty == 2) {
                            *(u32x4*)(HI + (size_t)row * 512 + cc) = pack8(v0, v1);
                        } else {
#pragma unroll
                            for (int j = 0; j < 4; ++j) { v0[j] = sigmoidf_(v0[j]); v1[j] = sigmoidf_(v1[j]); }
                            *(u32x4*)(OG + (size_t)row * 512 + cc) = pack8(v0, v1);
                        }
                    } else {
                        const int gc = col - (RP + 2048);
#pragma unroll
                        for (int j = 0; j < 4; ++j) { v0[j] = sigmoidf_(v0[j]); v1[j] = sigmoidf_(v1[j]); }
                        if (row < M) *(u32x4*)(GATE + (size_t)row * 2048 + gc) = pack8(v0, v1);
                    }
                }
            }
    }
};

template <bool SECOND> struct EpiMerge {
    static constexpr bool PERM = true, AFTER_DRAIN = false;
    bf16_t* MG; const bf16_t* GATE;
    __device__ __forceinline__ void operator()(AccRef acc, const Unit& u, int wr, int wc, int fr, int fq) const {
        const int row0 = u.pm * 256 + wr * 64 + fr, cl = wc * 32 + 8 * fq;
#pragma unroll
        for (int ai = 0; ai < 2; ++ai)
#pragma unroll
            for (int mh = 0; mh < 2; ++mh) {
                u32x4 gv[2][2], pv[2][2];
#pragma unroll
                for (int mm = 0; mm < 2; ++mm) {
                    const int row = row0 + ai * 128 + (2 * mh + mm) * 16, rg = row < M ? row : M - 1;
#pragma unroll
                    for (int bj = 0; bj < 2; ++bj) {
                        const int col = u.pn * 256 + bj * 128 + cl;
                        gv[mm][bj] = *(const u32x4*)(GATE + (size_t)rg * 2048 + (SECOND ? 1024 : 0) + col);
                        if (SECOND) pv[mm][bj] = *(const u32x4*)(MG + (size_t)row * D + col);
                    }
                }
#pragma unroll
                for (int mm = 0; mm < 2; ++mm) {
                    const int m = 2 * mh + mm, row = row0 + ai * 128 + m * 16;
#pragma unroll
                    for (int bj = 0; bj < 2; ++bj) {
                        const int col = u.pn * 256 + bj * 128 + cl;
                        f32x4 g0, g1; unpack8(gv[mm][bj], g0, g1);
                        f32x4 v0 = acc[ai][bj][m][0] * g0, v1 = acc[ai][bj][m][1] * g1;
                        if (SECOND) { f32x4 p0, p1; unpack8(pv[mm][bj], p0, p1); v0 += p0; v1 += p1; }
                        *(u32x4*)(MG + (size_t)row * D + col) = pack8(v0, v1);
                    }
                }
            }
    }
};

struct EpiOut {
    static constexpr bool PERM = false, AFTER_DRAIN = false;
    const float* xp; const float* xs; float* X1; bf16_t* X1B; float* ssq;
    __device__ __forceinline__ void operator()(AccRef acc, const Unit& u, int wr, int wc, int fr, int fq) const {
        const int row0 = u.pm * 256 + wr * 64 + fr, col0 = u.pn * 256 + wc * 32 + 4 * fq;
#pragma unroll
        for (int ai = 0; ai < 2; ++ai)
#pragma unroll
            for (int mh = 0; mh < 2; ++mh) {
                f32x4 xv[2][2][2];
#pragma unroll
                for (int mm = 0; mm < 2; ++mm) {
                    const int row = row0 + ai * 128 + (2 * mh + mm) * 16, rc = row < M ? row : M - 1;
                    const float* xr = rc < TP ? xp + (size_t)rc * D : xs + (size_t)(rc - TP) * D;
#pragma unroll
                    for (int bj = 0; bj < 2; ++bj)
#pragma unroll
                        for (int n = 0; n < 2; ++n) xv[mm][bj][n] = *(const f32x4*)(xr + col0 + bj * 128 + n * 16);
                }
#pragma unroll
                for (int mm = 0; mm < 2; ++mm) {
                    const int m = 2 * mh + mm, row = row0 + ai * 128 + m * 16;
                    const bool ok = row < M;
                    float ss = 0.f;
#pragma unroll
                    for (int bj = 0; bj < 2; ++bj)
#pragma unroll
                        for (int n = 0; n < 2; ++n) {
                            const int col = col0 + bj * 128 + n * 16;
                            const f32x4 v = xv[mm][bj][n] + acc[ai][bj][m][n];
                            ss += v[0] * v[0] + v[1] * v[1] + v[2] * v[2] + v[3] * v[3];
                            if (ok) *(f32x4*)(X1 + (size_t)row * D + col) = v;
                            u32x2 w; w.x = cvt_pk_bf16(v[0], v[1]); w.y = cvt_pk_bf16(v[2], v[3]);
                            *(u32x2*)(X1B + (size_t)row * D + col) = w;
                        }
                    ss += __shfl_xor(ss, 16); ss += __shfl_xor(ss, 32);
                    if (fq == 0) atomicAdd(ssq + row, ss);
                }
            }
    }
};

struct EpiGU {
    static constexpr bool PERM = true, AFTER_DRAIN = false;
    bf16_t* ACT; const float* ssq;
    __device__ __forceinline__ void operator()(AccRef acc, const Unit& u, int wr, int wc, int fr, int fq) const {
        const int row0 = u.pm * 256 + wr * 64 + fr, col = u.pn * 128 + wc * 32 + 8 * fq;
#pragma unroll
        for (int ai = 0; ai < 2; ++ai)
#pragma unroll
            for (int m = 0; m < 4; ++m) {
                const int row = row0 + ai * 128 + m * 16;
                const float rstd = rsqrtf(ssq[row] * (1.f / D) + 1e-6f);
                f32x4 o[2];
#pragma unroll
                for (int n = 0; n < 2; ++n)
#pragma unroll
                    for (int j = 0; j < 4; ++j) { const float g = acc[ai][0][m][n][j] * rstd, uu = acc[ai][1][m][n][j] * rstd; o[n][j] = g * sigmoidf_(g) * uu; }
                *(u32x4*)(ACT + (size_t)row * DFF + col) = pack8(o[0], o[1]);
            }
    }
};

struct EpiDown {
    static constexpr bool PERM = false, AFTER_DRAIN = false;
    float* X;
    __device__ __forceinline__ void operator()(AccRef acc, const Unit& u, int wr, int wc, int fr, int fq) const {
        const int row0 = u.pm * 256 + wr * 64 + fr, col0 = u.pn * 256 + wc * 32 + 4 * fq;
#pragma unroll
        for (int ai = 0; ai < 2; ++ai)
#pragma unroll
            for (int mh = 0; mh < 2; ++mh) {
                f32x4 xv[2][2][2];
#pragma unroll
                for (int mm = 0; mm < 2; ++mm) {
                    const int row = row0 + ai * 128 + (2 * mh + mm) * 16, rc = row < M ? row : M - 1;
#pragma unroll
                    for (int bj = 0; bj < 2; ++bj)
#pragma unroll
                        for (int n = 0; n < 2; ++n) xv[mm][bj][n] = *(const f32x4*)(X + (size_t)rc * D + col0 + bj * 128 + n * 16);
                }
#pragma unroll
                for (int mm = 0; mm < 2; ++mm) {
                    const int m = 2 * mh + mm, row = row0 + ai * 128 + m * 16;
                    if (row < M) {
#pragma unroll
                        for (int bj = 0; bj < 2; ++bj)
#pragma unroll
                            for (int n = 0; n < 2; ++n) *(f32x4*)(X + (size_t)row * D + col0 + bj * 128 + n * 16) = xv[mm][bj][n] + acc[ai][bj][m][n];
                    }
                }
            }
    }
};


__device__ void phase_lora_inputs(const Params& p) {
    const bf16_t* PR = (const bf16_t*)(p.ws + WS_PR); bf16_t* LIN = (bf16_t*)(p.ws + WS_LIN);
    const float* mu = p.in[7]; const float* shs = p.in[3];
    for (int idx = blockIdx.x * NTHR + tidx(); idx < M * 32; idx += gridDim.x * NTHR) {
        const int row = idx >> 5, gq = idx & 31, col = 1536 + 8 * gq;
        const bool first = row >= TP || (row & (SEQ - 1)) == 0;
        const u32x4 cw = *(const u32x4*)(PR + (size_t)row * RP + col), pw = *(const u32x4*)(PR + (size_t)(row - (first ? 0 : 1)) * RP + col);
        const int sr = row >= TP ? row - TP : 0;
        const f32x4 z0 = *(const f32x4*)(shs + (size_t)sr * RP + col), z1 = *(const f32x4*)(shs + (size_t)sr * RP + col + 4);
        const f32x4 m0 = *(const f32x4*)(mu + col), m1 = *(const f32x4*)(mu + col + 4);
        f32x4 c0, c1, q0, q1; unpack8(cw, c0, c1); unpack8(pw, q0, q1);
        if (first) { if (row >= TP) { q0 = z0; q1 = z1; } else { q0 = (f32x4){0.f, 0.f, 0.f, 0.f}; q1 = q0; } }
        f32x4 s0 = c0 + m0 * (q0 - c0), s1 = c1 + m1 * (q1 - c1);
        if (gq < 8 || gq >= 16) {
            const bool th = gq < 8; const float ksc = th ? 2.f : 1.f, asc = th ? 2.f : 1.f, bsc = th ? -1.f : 0.f;
#pragma unroll
            for (int q = 0; q < 4; ++q) { s0[q] = asc * sigmoidf_(ksc * s0[q]) + bsc; s1[q] = asc * sigmoidf_(ksc * s1[q]) + bsc; }
        }
        *(u32x4*)(LIN + (size_t)row * 256 + 8 * gq) = pack8(s0, s1);
    }
}
struct EpiLora {
    static constexpr bool PERM = true, AFTER_DRAIN = false;
    bf16_t* LD; bf16_t* AA; bf16_t* GG; const float* w0; const float* a0;
    __device__ __forceinline__ void operator()(AccRef acc, const Unit& u, int wr, int wc, int fr, int fq) const {
        const int row0 = u.pm * 256 + wr * 64 + fr, cl = wc * 32 + 8 * fq, ty = u.pn >> 1;
#pragma unroll
        for (int bj = 0; bj < 2; ++bj) {
            const int cc = (u.pn & 1) * 256 + bj * 128 + cl;
            f32x4 b0 = {0.f, 0.f, 0.f, 0.f}, b1 = b0;
            if (ty == 0) { b0 = *(const f32x4*)(w0 + cc); b1 = *(const f32x4*)(w0 + cc + 4); } else if (ty == 1) { b0 = *(const f32x4*)(a0 + cc); b1 = *(const f32x4*)(a0 + cc + 4); }
#pragma unroll
            for (int ai = 0; ai < 2; ++ai)
#pragma unroll
                for (int m = 0; m < 4; ++m) {
                    const int row = row0 + ai * 128 + m * 16;
                    f32x4 v0 = acc[ai][bj][m][0] + b0, v1 = acc[ai][bj][m][1] + b1;
                    if (ty == 0) {
#pragma unroll
                        for (int q = 0; q < 4; ++q) { const float z0 = -v0[q], z1 = -v1[q];
                            v0[q] = -__expf(-(fmaxf(z0, 0.f) + __logf(1.f + __expf(-fabsf(z0)))) - 0.5f); v1[q] = -__expf(-(fmaxf(z1, 0.f) + __logf(1.f + __expf(-fabsf(z1)))) - 0.5f); }
                    } else if (ty == 1) {
#pragma unroll
                        for (int q = 0; q < 4; ++q) { v0[q] = sigmoidf_(v0[q]); v1[q] = sigmoidf_(v1[q]); }
                    }
                    const u32x4 w = pack8(v0, v1);
                    if (ty == 0) *(u32x4*)(LD + (size_t)row * 512 + cc) = w; else if (ty == 1) *(u32x4*)(AA + (size_t)row * 512 + cc) = w; else *(u32x4*)(GG + (size_t)row * 512 + cc) = w;
                }
        }
    }
};

__device__ __forceinline__ f32x4 mfma16(const bf16x8 a, const bf16x8 b, const f32x4 c) { return __builtin_amdgcn_mfma_f32_16x16x32_bf16(a, b, c, 0, 0, 0); }

__device__ void rwkv_seq_item(const Params& p, unsigned char* lds, int row0, int T, int h, const float* __restrict__ S_init, const float* __restrict__ shift_prev, float* __restrict__ S_out, int half) {
#define RW_BAR() do { asm volatile("s_waitcnt lgkmcnt(0)" ::: "memory"); __builtin_amdgcn_s_barrier(); asm volatile("" ::: "memory"); } while (0)
    constexpr int BUFB = 9 * 4096;
    float* sA = (float*)(lds + 73728);
    bf16_t* sTW = (bf16_t*)(lds + 77824); bf16_t* sAD = (bf16_t*)(lds + 80128); bf16_t* sSG = (bf16_t*)(lds + 82432);
    bf16_t* w2t = (bf16_t*)(lds + 86784); bf16_t* a2t = (bf16_t*)(lds + 96000); bf16_t* g2t = (bf16_t*)(lds + 105216);
    float* sMu = (float*)(lds + 122624); float* sCst = (float*)(lds + 124416);
    const int tid = tidx(), lane = tid & 63, wave = __builtin_amdgcn_readfirstlane(tid >> 6);
    const bf16_t* PR = (const bf16_t*)(p.ws + WS_PR);
    bf16_t* OA = (bf16_t*)(p.ws + WS_OA);
    const float *mu = p.in[7], *w0 = p.in[8], *w2 = p.in[9], *a0 = p.in[10], *a2 = p.in[11], *g2 = p.in[12], *k_k = p.in[13], *k_a = p.in[14], *r_k = p.in[15], *ln_g = p.in[16], *ln_b = p.in[17];
    __syncthreads();
    if (tid < 448) { const int j = tid; sMu[j] = mu[j < 64 ? 64 * h + j : (j < 128 ? 512 + 64 * h + (j - 64) : (j < 192 ? 1024 + 64 * h + (j - 128) : 1536 + (j - 192)))]; }
    else if (tid < 512) { const int c = tid - 448, cg = 64 * h + c; sCst[c] = k_k[cg]; sCst[64 + c] = k_a[cg]; sCst[128 + c] = r_k[cg]; sCst[192 + c] = ln_g[cg]; sCst[256 + c] = ln_b[cg]; sCst[320 + c] = w0[cg]; sCst[384 + c] = a0[cg]; }
    __syncthreads();
    const int NC = (T + 15) >> 4;
    if (wave < 4) {
        __builtin_amdgcn_s_setprio(2);
        const bool full = half < 0;
        const int rA = full ? 16 * wave + 2 * (lane >> 3) : 32 * half + 8 * wave + (lane >> 3), rB = full ? rA + 1 : rA, kp = lane & 7, lo = kp * 8;
        f2 SA[4], SB[4];
        if (S_init) {
            const f32x4 a0_ = *(const f32x4*)(S_init + rA * 64 + lo), a1_ = *(const f32x4*)(S_init + rA * 64 + lo + 4), b0_ = *(const f32x4*)(S_init + rB * 64 + lo), b1_ = *(const f32x4*)(S_init + rB * 64 + lo + 4);
            SA[0] = (f2){a0_[0], a0_[1]}; SA[1] = (f2){a0_[2], a0_[3]}; SA[2] = (f2){a1_[0], a1_[1]}; SA[3] = (f2){a1_[2], a1_[3]};
            SB[0] = (f2){b0_[0], b0_[1]}; SB[1] = (f2){b0_[2], b0_[3]}; SB[2] = (f2){b1_[0], b1_[1]}; SB[3] = (f2){b1_[2], b1_[3]};
        } else {
#pragma unroll
            for (int j = 0; j < 4; ++j) { SA[j] = (f2){0.f, 0.f}; SB[j] = (f2){0.f, 0.f}; }
        }
#define RW_LD(P, tt) P##d0 = *(const f32x4*)(bR + 3 * 1024 + (tt) * 64 + lo); P##d1 = *(const f32x4*)(bR + 3 * 1024 + (tt) * 64 + lo + 4); P##k0 = *(const f32x4*)(bR + 4 * 1024 + (tt) * 64 + lo); P##k1 = *(const f32x4*)(bR + 4 * 1024 + (tt) * 64 + lo + 4); \
        P##b0 = *(const f32x4*)(bR + 5 * 1024 + (tt) * 64 + lo); P##b1 = *(const f32x4*)(bR + 5 * 1024 + (tt) * 64 + lo + 4); P##q0 = *(const f32x4*)(bR + 1024 + (tt) * 64 + lo); P##q1 = *(const f32x4*)(bR + 1024 + (tt) * 64 + lo + 4); \
        P##r0 = *(const f32x4*)(bR + (tt) * 64 + lo); P##r1 = *(const f32x4*)(bR + (tt) * 64 + lo + 4); P##vv[0] = bR[2 * 1024 + (tt) * 64 + rA]; P##vv[1] = bR[2 * 1024 + (tt) * 64 + rB];
#define RW_ROW(S_, P, vsc, yout) {   \
        const f2 vvv = {vsc, vsc}; \
        const f2 t0_ = S_[0] * (f2){P##d0[0], P##d0[1]} + vvv * (f2){P##q0[0], P##q0[1]}, t1_ = S_[1] * (f2){P##d0[2], P##d0[3]} + vvv * (f2){P##q0[2], P##q0[3]}; \
        const f2 t2_ = S_[2] * (f2){P##d1[0], P##d1[1]} + vvv * (f2){P##q1[0], P##q1[1]}, t3_ = S_[3] * (f2){P##d1[2], P##d1[3]} + vvv * (f2){P##q1[2], P##q1[3]}; \
        const f2 sa2 = (S_[0] * (f2){P##k0[0], P##k0[1]} + S_[1] * (f2){P##k0[2], P##k0[3]}) + (S_[2] * (f2){P##k1[0], P##k1[1]} + S_[3] * (f2){P##k1[2], P##k1[3]}); \
        const float sa = -red8(sa2[0] + sa2[1]); const f2 sav = {sa, sa}; \
        S_[0] = t0_ + sav * (f2){P##b0[0], P##b0[1]}; S_[1] = t1_ + sav * (f2){P##b0[2], P##b0[3]}; S_[2] = t2_ + sav * (f2){P##b1[0], P##b1[1]}; S_[3] = t3_ + sav * (f2){P##b1[2], P##b1[3]}; \
        const f2 y2 = (S_[0] * (f2){P##r0[0], P##r0[1]} + S_[1] * (f2){P##r0[2], P##r0[3]}) + (S_[2] * (f2){P##r1[0], P##r1[1]} + S_[3] * (f2){P##r1[2], P##r1[3]}); \
        yout = red8(y2[0] + y2[1]); }
#define RW_STEP(P, tt) { float yA_, yB_; RW_ROW(SA, P, P##vv[0], yA_) ((float*)bR)[8 * 1024 + (tt) * 64 + rA] = yA_; if (full) { RW_ROW(SB, P, P##vv[1], yB_) ((float*)bR)[8 * 1024 + (tt) * 64 + rB] = yB_; } }
#define RW_PAIR(t) { RW_LD(B, (t) + 1) RW_STEP(A, (t)) RW_LD(A, ((t) + 2) & 15) RW_STEP(B, (t) + 1) }
        f32x4 Ad0, Ad1, Ak0, Ak1, Ab0, Ab1, Aq0, Aq1, Ar0, Ar1, Bd0, Bd1, Bk0, Bk1, Bb0, Bb1, Bq0, Bq1, Br0, Br1; f2 Avv, Bvv;
        for (int c = 0; c <= NC + 1; ++c) {
            if (c >= 1 && c <= NC) {
                const int cc = c - 1, nt = (T - 16 * cc) < 16 ? (T - 16 * cc) : 16;
                const float* bR = (const float*)(lds + (cc & 1) * BUFB);
                if (nt == 16) {
                    RW_LD(A, 0)
                    RW_PAIR(0) RW_PAIR(2) RW_PAIR(4) RW_PAIR(6)
                    RW_BAR();
                    RW_PAIR(8) RW_PAIR(10) RW_PAIR(12) RW_PAIR(14)
                    RW_BAR();
                } else {
                    for (int t = 0; t < nt; ++t) { RW_LD(A, t) RW_STEP(A, t) }
                    RW_BAR(); RW_BAR();
                }
            } else { RW_BAR(); RW_BAR(); }
        }
#undef RW_LD
#undef RW_ROW
#undef RW_STEP
#undef RW_PAIR
        __builtin_amdgcn_s_setprio(0);
        float* so = S_out + rA * 64 + lo;
        *(f32x4*)so = (f32x4){SA[0][0], SA[0][1], SA[1][0], SA[1][1]}; *(f32x4*)(so + 4) = (f32x4){SA[2][0], SA[2][1], SA[3][0], SA[3][1]};
        if (full) { *(f32x4*)(so + 64) = (f32x4){SB[0][0], SB[0][1], SB[1][0], SB[1][1]}; *(f32x4*)(so + 68) = (f32x4){SB[2][0], SB[2][1], SB[3][0], SB[3][1]}; }
    } else {
        const int ptid = tid - 256, pw = wave - 4;
        float* sBon = (float*)(lds + 126208);
        bf16_t* Yg = (bf16_t*)(p.ws + WS_OA); float* BONg = (float*)(p.ws + WS_BON);
        u32x4 pfc[2], pfp[2], pfl[2], pfcB[2], pfpB[2], pflB[2];
        const bf16_t* LDg = (const bf16_t*)(p.ws + WS_LD); const bf16_t* AAg = (const bf16_t*)(p.ws + WS_AA); const bf16_t* GGg = (const bf16_t*)(p.ws + WS_GG);
#define RW_COL(gi_) ((gi_) < 8 ? 64 * h + 8 * (gi_) : ((gi_) < 16 ? 512 + 64 * h + 8 * ((gi_) - 8) : ((gi_) < 24 ? 1024 + 64 * h + 8 * ((gi_) - 16) : 1536 + 8 * ((gi_) - 24))))
#define RW_GI(i_, j_) ((i_) == 0 ? (j_) : ((i_) == 1 ? ((j_) < 8 ? 16 + (j_) : 24 + (j_)) : ((i_) == 2 ? ((j_) < 8 ? 24 + (j_) : 32 + (j_)) : 48 + ((j_) & 7))))
#define RW_PREFETCH(cn) do { const int tb_ = 16 * (cn); const int ntn_ = (T - tb_) < 16 ? (T - tb_) : 16; const int t_ = (ptid >> 4) < ntn_ ? (ptid >> 4) : ntn_ - 1;   \
        const size_t row_ = (size_t)row0 + tb_ + t_; const size_t rowp_ = row_ - (tb_ + t_ > 0 ? 1 : 0); \
        _Pragma("unroll") for (int i_ = 0; i_ < 2; ++i_) { const int gi_ = (ptid & 15) + 8 * i_ * (1 + (((ptid & 15) < 8) ? 1 : 0));   \
            const int col_ = RW_COL(gi_); pfc[i_] = *(const u32x4*)(PR + row_ * RP + col_); pfp[i_] = *(const u32x4*)(PR + rowp_ * RP + col_); } \
        } while (0)
#define RW_PREFETCH_L(cn) do { const int tb_ = 16 * (cn); const int ntn_ = (T - tb_) < 16 ? (T - tb_) : 16; const int t2_ = ((ptid >> 3) & 15) < ntn_ ? ((ptid >> 3) & 15) : ntn_ - 1; \
        const size_t o_ = ((size_t)row0 + tb_ + t2_) * 512 + 64 * h + 8 * (ptid & 7); pfl[0] = *(const u32x4*)(((ptid >> 7) ? AAg : LDg) + o_); pfl[1] = *(const u32x4*)(GGg + o_); } while (0)
        RW_PREFETCH(0); RW_PREFETCH_L(0);
        if (NC > 1) { auto pf1 = [&](u32x4 (&pfc)[2], u32x4 (&pfp)[2], u32x4 (&pfl)[2]) __attribute__((always_inline)) { RW_PREFETCH(1); RW_PREFETCH_L(1); }; pf1(pfcB, pfpB, pflB); }
        auto prep_iter = [&](const int c, u32x4 (&pfc)[2], u32x4 (&pfp)[2], u32x4 (&pfl)[2]) __attribute__((always_inline)) {
            if (c >= 2) {
                const int cc = c - 2, nt = (T - 16 * cc) < 16 ? (T - 16 * cc) : 16;
                const float* bR = (const float*)(lds + (cc & 1) * BUFB);
                if (half >= 0) {
                    if (ptid < 8 * nt) {
                        const int t = ptid >> 3, c8 = 8 * (ptid & 7); const size_t grow = (size_t)row0 + 16 * cc + t;
                        if (((ptid & 7) >> 2) == half) *(u32x4*)(Yg + grow * 512 + 64 * h + c8) = pack8(*(const f32x4*)(bR + 8 * 1024 + t * 64 + c8), *(const f32x4*)(bR + 8 * 1024 + t * 64 + c8 + 4));
                        if (half == 0 && (ptid & 7) == 0) BONg[grow * 8 + h] = sBon[(cc & 1) * 16 + t];
                    }
                } else
                if (ptid < 8 * nt) {
                    const int t = ptid >> 3, c8 = 8 * (ptid & 7);
                    const f32x4 y0 = *(const f32x4*)(bR + 8 * 1024 + t * 64 + c8), y1 = *(const f32x4*)(bR + 8 * 1024 + t * 64 + c8 + 4);
                    const float mean = red8((y0[0] + y0[1]) + (y0[2] + y0[3]) + (y1[0] + y1[1]) + (y1[2] + y1[3])) * (1.f / 64.f);
                    const f32x4 d0 = y0 - mean, d1 = y1 - mean, dq = d0 * d0 + d1 * d1;
                    const float var = red8((dq[0] + dq[1]) + (dq[2] + dq[3])) * (1.f / 64.f);
                    const float rs = rsqrtf(var + 64e-5f);
                    const f32x4 lg0 = *(const f32x4*)(sCst + 192 + c8), lg1 = *(const f32x4*)(sCst + 192 + c8 + 4), lb0 = *(const f32x4*)(sCst + 256 + c8), lb1 = *(const f32x4*)(sCst + 256 + c8 + 4);
                    const f32x4 bv0 = *(const f32x4*)(bR + 7 * 1024 + t * 64 + c8), bv1 = *(const f32x4*)(bR + 7 * 1024 + t * 64 + c8 + 4), g0 = *(const f32x4*)(bR + 6 * 1024 + t * 64 + c8), g1 = *(const f32x4*)(bR + 6 * 1024 + t * 64 + c8 + 4);
                    const f32x4 o0 = (d0 * rs * lg0 + lb0 + bv0) * g0, o1 = (d1 * rs * lg1 + lb1 + bv1) * g1;
                    *(u32x4*)(OA + ((size_t)row0 + 16 * cc + t) * 512 + 64 * h + c8) = pack8(o0, o1);
                }
            }
            const bool act = c < NC;
            const int nt = act ? ((T - 16 * c) < 16 ? (T - 16 * c) : 16) : 0;
            float* bW = (float*)(lds + (c & 1) * BUFB);
            if (act) {
                {
                    const int t = ptid >> 4, j = ptid & 15;
                    if (t < nt) {
#pragma unroll
                        for (int i1 = 0; i1 < 2; ++i1) {
                            if (i1 == 0 || j < 8) {
                                const int gi = j + 16 * i1;
                                f32x4 c0, c1, p0, p1;
                                unpack8(pfc[i1], c0, c1);
                                if (16 * c + t == 0) { if (shift_prev) { const int col = RW_COL(gi); p0 = *(const f32x4*)(shift_prev + col); p1 = *(const f32x4*)(shift_prev + col + 4); } else { p0 = (f32x4){0.f, 0.f, 0.f, 0.f}; p1 = p0; } }
                                else unpack8(pfp[i1], p0, p1);
                                const f32x4 m0 = *(const f32x4*)(sMu + 8 * gi), m1 = *(const f32x4*)(sMu + 8 * gi + 4);
                                const f32x4 s0 = c0 + m0 * (p0 - c0), s1 = c1 + m1 * (p1 - c1);
                                float* d = bW + (gi >> 3) * 1024 + t * 64 + 8 * (gi & 7); *(f32x4*)d = s0; *(f32x4*)(d + 4) = s1;
                            }
                        }
                    }
                }
                if (c + 2 < NC) RW_PREFETCH(c + 2);
                    const int t2 = (ptid >> 3) & 15, c8 = 8 * (ptid & 7);
                    if (t2 < nt) {
                        f32x4 x0, x1; unpack8(pfl[0], x0, x1);
                        if (ptid >> 7) { *(f32x4*)(sA + t2 * 64 + c8) = x0; *(f32x4*)(sA + t2 * 64 + c8 + 4) = x1; }
                        else {
#pragma unroll
                            for (int q = 0; q < 4; ++q) { x0[q] = __expf(x0[q]); x1[q] = __expf(x1[q]); }
                            *(f32x4*)(bW + 3 * 1024 + t2 * 64 + c8) = x0; *(f32x4*)(bW + 3 * 1024 + t2 * 64 + c8 + 4) = x1;
                            f32x4 g0, g1; unpack8(pfl[1], g0, g1);
                            *(f32x4*)(bW + 6 * 1024 + t2 * 64 + c8) = g0; *(f32x4*)(bW + 6 * 1024 + t2 * 64 + c8 + 4) = g1;
                        }
                    }
                if (c + 2 < NC) RW_PREFETCH_L(c + 2);
            }
            RW_BAR();
            if (act && ptid < 8 * nt) {
                const int t = ptid >> 3, c8 = 8 * (ptid & 7);
                f32x4 k0 = *(const f32x4*)(bW + 1024 + t * 64 + c8), k1 = *(const f32x4*)(bW + 1024 + t * 64 + c8 + 4);
                const f32x4 a0v = *(const f32x4*)(sA + t * 64 + c8), a1v = *(const f32x4*)(sA + t * 64 + c8 + 4);
                const f32x4 r0 = *(const f32x4*)(bW + t * 64 + c8), r1 = *(const f32x4*)(bW + t * 64 + c8 + 4);
                const f32x4 v0 = *(const f32x4*)(bW + 2 * 1024 + t * 64 + c8), v1 = *(const f32x4*)(bW + 2 * 1024 + t * 64 + c8 + 4);
                const f32x4 kk0 = *(const f32x4*)(sCst + c8), kk1 = *(const f32x4*)(sCst + c8 + 4), ka0 = *(const f32x4*)(sCst + 64 + c8), ka1 = *(const f32x4*)(sCst + 64 + c8 + 4);
                const f32x4 rk0 = *(const f32x4*)(sCst + 128 + c8), rk1 = *(const f32x4*)(sCst + 128 + c8 + 4);
                f32x4 n0 = k0 * kk0, n1 = k1 * kk1;
                const f32x4 sq = n0 * n0 + n1 * n1;
                const float n2 = red8((sq[0] + sq[1]) + (sq[2] + sq[3]));
                const float inv = __builtin_amdgcn_rcpf(fmaxf(sqrtf(n2), 1e-12f));
                n0 *= inv; n1 *= inv;
                k0 = k0 * (1.f + (a0v - 1.f) * ka0); k1 = k1 * (1.f + (a1v - 1.f) * ka1);
                const f32x4 bs = r0 * k0 * rk0 + r1 * k1 * rk1;
                const float bon = red8((bs[0] + bs[1]) + (bs[2] + bs[3]));
                *(f32x4*)(bW + 1024 + t * 64 + c8) = k0; *(f32x4*)(bW + 1024 + t * 64 + c8 + 4) = k1;
                *(f32x4*)(bW + 4 * 1024 + t * 64 + c8) = n0; *(f32x4*)(bW + 4 * 1024 + t * 64 + c8 + 4) = n1;
                *(f32x4*)(bW + 5 * 1024 + t * 64 + c8) = n0 * a0v; *(f32x4*)(bW + 5 * 1024 + t * 64 + c8 + 4) = n1 * a1v;
                *(f32x4*)(bW + 7 * 1024 + t * 64 + c8) = v0 * bon; *(f32x4*)(bW + 7 * 1024 + t * 64 + c8 + 4) = v1 * bon;
                if ((ptid & 7) == 0) sBon[(c & 1) * 16 + t] = bon;
            }
            RW_BAR();
                };
        for (int c = 0; c <= NC + 1; c += 2) { prep_iter(c, pfc, pfp, pfl); if (c + 1 <= NC + 1) prep_iter(c + 1, pfcB, pfpB, pflB); }
        __builtin_amdgcn_s_setprio(0);
#undef RW_PREFETCH
#undef RW_PREFETCH_L
#undef RW_COL
#undef RW_GI
#undef RW_BAR
    }
    __syncthreads();
}

__device__ void hgrn_seq_item(const Params& p, unsigned char* lds, int row0, int T, int h, const float* __restrict__ S_init, float* __restrict__ S_out) {
    float* sF = (float*)lds; float* sQ = sF + 4096; float* sI = sQ + 4096; float* sO = sI + 4096;
    const int tid = tidx(), lane = tid & 63, wave = tid >> 6, col = tid >> 2, kp = tid & 3;
    const float* F = (const float*)(p.ws + WS_F); const bf16_t* QS = (const bf16_t*)(p.ws + WS_QS); const bf16_t* HI = (const bf16_t*)(p.ws + WS_HI);
    const bf16_t* OG = (const bf16_t*)(p.ws + WS_OG); bf16_t* OB = (bf16_t*)(p.ws + WS_OB); const float* norm_g = p.in[20];
    float S[32];
#pragma unroll
    for (int j = 0; j < 32; ++j) S[j] = S_init ? S_init[(32 * kp + j) * 128 + col] : 0.f;
    __syncthreads();
    for (int t0 = 0; t0 < T; t0 += 32) {
        const int nt = (T - t0) < 32 ? (T - t0) : 32;
        for (int idx = tid; idx < nt * 128; idx += NTHR) { const int t = idx >> 7, c = idx & 127; const size_t o = ((size_t)row0 + t0 + t) * 512 + 128 * h + c;
            sF[idx] = F[o]; sQ[idx] = bf2f(QS[o]); sI[idx] = bf2f(HI[o]); }
        __syncthreads();
        for (int t = 0; t < nt; ++t) {
            const float iv = sI[t * 128 + col]; float o = 0.f;
#pragma unroll
            for (int j4 = 0; j4 < 8; ++j4) {
                const float4 f = *(const float4*)(sF + t * 128 + 32 * kp + 4 * j4), q = *(const float4*)(sQ + t * 128 + 32 * kp + 4 * j4);
                S[4 * j4 + 0] = f.x * S[4 * j4 + 0] + (1.f - f.x) * iv; o += q.x * S[4 * j4 + 0];
                S[4 * j4 + 1] = f.y * S[4 * j4 + 1] + (1.f - f.y) * iv; o += q.y * S[4 * j4 + 1];
                S[4 * j4 + 2] = f.z * S[4 * j4 + 2] + (1.f - f.z) * iv; o += q.z * S[4 * j4 + 2];
                S[4 * j4 + 3] = f.w * S[4 * j4 + 3] + (1.f - f.w) * iv; o += q.w * S[4 * j4 + 3];
            }
            o += dppf<0xB1>(o); o += dppf<0x4E>(o);
            if (kp == 0) sO[t * 128 + col] = o;
        }
        __syncthreads();
        for (int t = wave; t < nt; t += 8) {
            const float o1 = sO[t * 128 + lane], o2 = sO[t * 128 + 64 + lane];
            const float ss = wave_sum(o1 * o1 + o2 * o2);
            const float rstd = rsqrtf(ss * (1.f / 128.f) + 1e-6f);
            const size_t o = ((size_t)row0 + t0 + t) * 512 + 128 * h + lane;
            OB[o] = f2bf(o1 * rstd * norm_g[128 * h + lane] * bf2f(OG[o]));
            OB[o + 64] = f2bf(o2 * rstd * norm_g[128 * h + 64 + lane] * bf2f(OG[o + 64]));
        }
        __syncthreads();
    }
#pragma unroll
    for (int j = 0; j < 32; ++j) S_out[(32 * kp + j) * 128 + col] = S[j];
}

constexpr int HQ_OFF = 0, HK_OFF = 17408, HKH_OFF = 34816, HVT_OFF = 53248, HP_OFF = 71680, HS_OFF = 80896, HD_OFF = 115712, HSEG_OFF = 116224, HSS_OFF = 118272;
__device__ void hgrn_chunk_item(const Params& p, unsigned char* lds, int b, int h) {
    bf16_t* Qt = (bf16_t*)(lds + HQ_OFF);
    bf16_t* Kt = (bf16_t*)(lds + HK_OFF);
    bf16_t* KhT = (bf16_t*)(lds + HKH_OFF);
    bf16_t* VT = (bf16_t*)(lds + HVT_OFF);
    bf16_t* Pm = (bf16_t*)(lds + HP_OFF);
    bf16_t* S0T = (bf16_t*)(lds + HS_OFF);
    float* dk = (float*)(lds + HD_OFF);
    float* segt = (float*)(lds + HSEG_OFF);
    float* ssp = (float*)(lds + HSS_OFF);
    const int tid = tidx(), lane = tid & 63, wave = tid >> 6, li = lane & 15, lq = lane >> 4;
    const float* F = (const float*)(p.ws + WS_F); const bf16_t* QS = (const bf16_t*)(p.ws + WS_QS); const bf16_t* HI = (const bf16_t*)(p.ws + WS_HI);
    const bf16_t* OG = (const bf16_t*)(p.ws + WS_OG); bf16_t* OB = (bf16_t*)(p.ws + WS_OB); const float* norm_g = p.in[20];
    f32x4 Sacc[8];
#pragma unroll
    for (int i = 0; i < 8; ++i) Sacc[i] = (f32x4){0.f, 0.f, 0.f, 0.f};
    __syncthreads();
    for (int i = tid; i < 128 * 136 / 2; i += NTHR) ((unsigned*)S0T)[i] = 0u;
    const int kch = tid & 127, seg = tid >> 7;
    for (int c0 = 0; c0 < SEQ; c0 += 64) {
        const size_t rbase = (size_t)b * SEQ + c0;
        {
            float fv[16], cb[16]; float run = 0.f;
#pragma unroll
            for (int j = 0; j < 16; ++j) { fv[j] = F[(rbase + 16 * seg + j) * 512 + 128 * h + kch]; run += __logf(fv[j]); cb[j] = run; }
            segt[seg * 128 + kch] = run;
            __syncthreads();
            float off = 0.f, tot = 0.f;
#pragma unroll
            for (int s = 0; s < 4; ++s) { const float v = segt[s * 128 + kch]; tot += v; if (s < seg) off += v; }
            const float etot = __expf(tot);
            if (seg == 0) dk[kch] = etot;
            unsigned kh[8];
#pragma unroll
            for (int j = 0; j < 16; j += 2) {
                float kk2[2];
#pragma unroll
                for (int e = 0; e < 2; ++e) {
                    const float bb = off + cb[j + e], eb = __expf(bb), ieb = __builtin_amdgcn_rcpf(eb), kf = 1.f - fv[j + e];
                    const float q = bf2f(QS[(rbase + 16 * seg + j + e) * 512 + 128 * h + kch]);
                    Qt[(16 * seg + j + e) * 136 + kch] = f2bf(q * eb);
                    Kt[(16 * seg + j + e) * 136 + kch] = f2bf(kf * ieb);
                    kk2[e] = kf * ieb * etot;
                }
                kh[j >> 1] = cvt_pk_bf16(kk2[0], kk2[1]);
            }
            *(u32x4*)(KhT + kch * 72 + 16 * seg) = (u32x4){kh[0], kh[1], kh[2], kh[3]};
            *(u32x4*)(KhT + kch * 72 + 16 * seg + 8) = (u32x4){kh[4], kh[5], kh[6], kh[7]};
            unsigned vv[8];
#pragma unroll
            for (int j = 0; j < 16; j += 2) {
                const unsigned lo = HI[(rbase + 16 * seg + j) * 512 + 128 * h + kch], hi = HI[(rbase + 16 * seg + j + 1) * 512 + 128 * h + kch];
                vv[j >> 1] = lo | (hi << 16);
            }
            *(u32x4*)(VT + kch * 72 + 16 * seg) = (u32x4){vv[0], vv[1], vv[2], vv[3]};
            *(u32x4*)(VT + kch * 72 + 16 * seg + 8) = (u32x4){vv[4], vv[5], vv[6], vv[7]};
        }
        __syncthreads();
        {
            const int ti = wave >> 1;
#pragma unroll
            for (int u = 0; u < 2; ++u) {
                const int si = 2 * (wave & 1) + u;
                f32x4 acc = {0.f, 0.f, 0.f, 0.f};
                if (si <= ti) {
#pragma unroll
                    for (int ks = 0; ks < 4; ++ks)
                        acc = mfma16(*(const bf16x8*)(Kt + (16 * si + li) * 136 + 8 * lq + 32 * ks), *(const bf16x8*)(Qt + (16 * ti + li) * 136 + 8 * lq + 32 * ks), acc);
                }
                const int t = 16 * ti + li, s0 = 16 * si + 4 * lq;
                u32x2 w; w.x = cvt_pk_bf16(s0 + 0 <= t ? acc[0] : 0.f, s0 + 1 <= t ? acc[1] : 0.f); w.y = cvt_pk_bf16(s0 + 2 <= t ? acc[2] : 0.f, s0 + 3 <= t ? acc[3] : 0.f);
                *(u32x2*)(Pm + t * 72 + s0) = w;
            }
        }
        __syncthreads();
        {
            const int ti = wave & 3, vh = wave >> 2, t = 16 * ti + li;
            bf16x8 bq[4], bp[2];
#pragma unroll
            for (int ks = 0; ks < 4; ++ks) bq[ks] = *(const bf16x8*)(Qt + t * 136 + 8 * lq + 32 * ks);
#pragma unroll
            for (int ks = 0; ks < 2; ++ks) bp[ks] = *(const bf16x8*)(Pm + t * 72 + 8 * lq + 32 * ks);
            f32x4 o[4]; float ss = 0.f;
#pragma unroll
            for (int vt = 0; vt < 4; ++vt) {
                const int vr = 64 * vh + 16 * vt + li;
                f32x4 acc = {0.f, 0.f, 0.f, 0.f};
#pragma unroll
                for (int ks = 0; ks < 4; ++ks) acc = mfma16(*(const bf16x8*)(S0T + vr * 136 + 8 * lq + 32 * ks), bq[ks], acc);
#pragma unroll
                for (int ks = 0; ks < 2; ++ks) acc = mfma16(*(const bf16x8*)(VT + vr * 72 + 8 * lq + 32 * ks), bp[ks], acc);
                o[vt] = acc; ss += acc[0] * acc[0] + acc[1] * acc[1] + acc[2] * acc[2] + acc[3] * acc[3];
            }
            ss += __shfl_xor(ss, 16); ss += __shfl_xor(ss, 32);
            if (lq == 0) ssp[vh * 64 + t] = ss;
            __syncthreads();
            const float rstd = rsqrtf((ssp[t] + ssp[64 + t]) * (1.f / 128.f) + 1e-6f);
            const size_t orow = (rbase + t) * 512 + 128 * h;
#pragma unroll
            for (int vt = 0; vt < 4; ++vt) {
                const int v = 64 * vh + 16 * vt + 4 * lq;
                const f32x4 g = *(const f32x4*)(norm_g + 128 * h + v);
                const u32x2 og = *(const u32x2*)(OG + orow + v);
                u32x2 w;
                w.x = cvt_pk_bf16(o[vt][0] * rstd * g[0] * __uint_as_float(og.x << 16), o[vt][1] * rstd * g[1] * __uint_as_float(og.x & 0xffff0000u));
                w.y = cvt_pk_bf16(o[vt][2] * rstd * g[2] * __uint_as_float(og.y << 16), o[vt][3] * rstd * g[3] * __uint_as_float(og.y & 0xffff0000u));
                *(u32x2*)(OB + orow + v) = w;
            }
        }
        {
            const f32x4 dv = *(const f32x4*)(dk + 16 * wave + 4 * lq);
            bf16x8 ak[2];
#pragma unroll
            for (int ks = 0; ks < 2; ++ks) ak[ks] = *(const bf16x8*)(KhT + (16 * wave + li) * 72 + 8 * lq + 32 * ks);
#pragma unroll
            for (int vt = 0; vt < 8; ++vt) {
                f32x4 acc = Sacc[vt] * dv;
#pragma unroll
                for (int ks = 0; ks < 2; ++ks) acc = mfma16(ak[ks], *(const bf16x8*)(VT + (16 * vt + li) * 72 + 8 * lq + 32 * ks), acc);
                Sacc[vt] = acc;
                u32x2 w; w.x = cvt_pk_bf16(acc[0], acc[1]); w.y = cvt_pk_bf16(acc[2], acc[3]);
                *(u32x2*)(S0T + (16 * vt + li) * 136 + 16 * wave + 4 * lq) = w;
            }
        }
        __syncthreads();
    }
    float* so = p.out + O_HGP + (size_t)(b * 4 + h) * 16384;
#pragma unroll
    for (int vt = 0; vt < 8; ++vt)
#pragma unroll
        for (int j = 0; j < 4; ++j) so[(16 * wave + 4 * lq + j) * 128 + 16 * vt + li] = Sacc[vt][j];
}


struct Order2 {
    pg8::StaticOrder st; int sub, n, G, c;
    __device__ __forceinline__ void init(int pass, int N, int Gg, int cc) { sub = pass == 0; n = N / 256; G = Gg - 160; c = cc - 160; st.init(TP, N, Gg, cc); }
    __device__ __forceinline__ bool next(int i, Unit& u) const { if (sub) { const int L = i * G + c; if (L >= n) return false; u.pm = 64; u.pn = L; return true; } return st.next(i, u); }
    __device__ __forceinline__ void a_ready(const Unit&) const {}
    __device__ __forceinline__ void done(const Unit&) const {}
};
struct EpiMerge2 {
    static constexpr bool PERM = true, AFTER_DRAIN = false;
    bf16_t* MG; const bf16_t* GATE;
    __device__ __forceinline__ void operator()(AccRef acc, const Unit& u, int wr, int wc, int fr, int fq) const {
        if (u.pm >= 65) { const Unit v{u.pm - 65, u.pn - 4}; const EpiMerge<true> e{MG, GATE}; e(acc, v, wr, wc, fr, fq); }
        else { const EpiMerge<false> e{MG, GATE}; e(acc, u, wr, wc, fr, fq); }
    }
};
struct OrderMerge {
    Order2 o;
    __device__ __forceinline__ bool next(int i, Unit& u) const { if (!o.next(i >> 1, u)) return false; if (i & 1) { u.pm += 65; u.pn += 4; } return true; }
    __device__ __forceinline__ void a_ready(const Unit&) const {}
    __device__ __forceinline__ void done(const Unit&) const {}
};

__device__ __forceinline__ void sub_barrier(unsigned* ctr, unsigned target) {
    __syncthreads();
    if (tidx() == 0) {
        __threadfence();
        __hip_atomic_fetch_add(ctr, 1u, __ATOMIC_RELEASE, __HIP_MEMORY_SCOPE_AGENT);
        while (__hip_atomic_load(ctr, __ATOMIC_ACQUIRE, __HIP_MEMORY_SCOPE_AGENT) < target) __builtin_amdgcn_s_sleep(4);
        __threadfence();
    }
    __syncthreads();
}

__device__ void rwkv_post_pass(const Params& p) {
    const bf16_t* Gg = (const bf16_t*)(p.ws + WS_GG); const float* BONg = (const float*)(p.ws + WS_BON);
    const bf16_t* PR = (const bf16_t*)(p.ws + WS_PR); bf16_t* OA = (bf16_t*)(p.ws + WS_OA);
    const float *mu = p.in[7], *ln_g = p.in[16], *ln_b = p.in[17];
    for (int idx = blockIdx.x * NTHR + tidx(); idx < TP * 64; idx += gridDim.x * NTHR) {
        const int item = idx >> 3, row = item >> 3, h = item & 7, cg = 64 * h + 8 * (idx & 7);
        const u32x4 yw = *(const u32x4*)(OA + (size_t)row * 512 + cg), gw = *(const u32x4*)(Gg + (size_t)row * 512 + cg);
        const bool first = (row & (SEQ - 1)) == 0;
        const u32x4 pcw = *(const u32x4*)(PR + (size_t)row * RP + 1024 + cg), ppw = *(const u32x4*)(PR + (size_t)(row - (first ? 0 : 1)) * RP + 1024 + cg);
        const f32x4 m0 = *(const f32x4*)(mu + 1024 + cg), m1 = *(const f32x4*)(mu + 1024 + cg + 4);
        const f32x4 lg0 = *(const f32x4*)(ln_g + cg), lg1 = *(const f32x4*)(ln_g + cg + 4), lb0 = *(const f32x4*)(ln_b + cg), lb1 = *(const f32x4*)(ln_b + cg + 4);
        const float bon = BONg[(size_t)row * 8 + h];
        f32x4 y0, y1, c0, c1, q0, q1, g0, g1; unpack8(yw, y0, y1); unpack8(pcw, c0, c1); unpack8(ppw, q0, q1); unpack8(gw, g0, g1);
        if (first) { q0 = (f32x4){0.f, 0.f, 0.f, 0.f}; q1 = q0; }
        const f32x4 v0 = c0 + m0 * (q0 - c0), v1 = c1 + m1 * (q1 - c1);
        const float mean = red8((y0[0] + y0[1]) + (y0[2] + y0[3]) + (y1[0] + y1[1]) + (y1[2] + y1[3])) * (1.f / 64.f);
        const f32x4 d0 = y0 - mean, d1 = y1 - mean, dq = d0 * d0 + d1 * d1;
        const float var = red8((dq[0] + dq[1]) + (dq[2] + dq[3])) * (1.f / 64.f);
        const float rs = rsqrtf(var + 64e-5f);
        const f32x4 o0 = (d0 * rs * lg0 + lb0 + bon * v0) * g0, o1 = (d1 * rs * lg1 + lb1 + bon * v1) * g1;
        *(u32x4*)(OA + (size_t)row * 512 + cg) = pack8(o0, o1);
    }
}

__device__ void phase_mix_seq(const Params& p, unsigned char* lds) {
    const int blk = blockIdx.x;
    float* out = p.out;
    if (blk >= 128 && blk < 160) { const int i = blk - 128, b = i >> 2, h = i & 3; hgrn_chunk_item(p, lds, b, h); return; }
    int it, end, step;
    if (blk < 128) { it = blk; end = 128; step = 128; }
    else { it = 128 + blk - 160; end = 128 + 1536; step = gridDim.x - 160; }
#pragma nounroll
    for (; it < end; it += step) {
        if (it < 128 + 1024) {
            int row0, T, half; const float* si; const float* sp; float* so; int h;
            if (it < 128) { const int bh = it >> 1, b = bh >> 3; h = bh & 7; half = it & 1; row0 = b * SEQ; T = SEQ; si = nullptr; sp = nullptr; so = out + O_WKVP + (size_t)(b * 8 + h) * 4096; }
            else { const int j = it - 128, b = j >> 3; h = j & 7; half = -1; row0 = TP + b; T = 1; si = p.in[2] + (size_t)(b * 8 + h) * 4096; sp = p.in[3] + (size_t)b * RP; so = out + O_WKVS + (size_t)(b * 8 + h) * 4096; }
            rwkv_seq_item(p, lds, row0, T, h, si, sp, so, half);
        } else { const int j = it - 128 - 1024, b = j >> 2, h = j & 3;
            hgrn_seq_item(p, lds, TP + b, 1, h, p.in[4] + (size_t)(b * 4 + h) * 16384, out + O_HGS + (size_t)(b * 4 + h) * 16384); }
    }
}

__device__ void phase_final_norm(const Params& p) {
    const int lane = tidx() & 63, wave = tidx() >> 6;
    const float* g = p.in[27];
    float4 gg[4];
#pragma unroll
    for (int i = 0; i < 4; ++i) gg[i] = *(const float4*)(g + i * 256 + lane * 4);
    int row = blockIdx.x * 8 + wave;
    float4 v[4];
    { const int r0 = row < M ? row : M - 1;
#pragma unroll
      for (int i = 0; i < 4; ++i) v[i] = *(const float4*)(p.out + (size_t)r0 * D + i * 256 + lane * 4); }
    for (; row < M; row += gridDim.x * 8) {
        const int rn = row + gridDim.x * 8 < M ? row + gridDim.x * 8 : row;
        float4 nv[4];
#pragma unroll
        for (int i = 0; i < 4; ++i) nv[i] = *(const float4*)(p.out + (size_t)rn * D + i * 256 + lane * 4);
        float ss = 0.f;
#pragma unroll
        for (int i = 0; i < 4; ++i) ss += v[i].x * v[i].x + v[i].y * v[i].y + v[i].z * v[i].z + v[i].w * v[i].w;
        ss = wave_sum(ss);
        const float rstd = rsqrtf(ss * (1.f / D) + 1e-6f);
        float* x = p.out + (size_t)row * D;
#pragma unroll
        for (int i = 0; i < 4; ++i) *(float4*)(x + i * 256 + lane * 4) = make_float4(v[i].x * rstd * gg[i].x, v[i].y * rstd * gg[i].y, v[i].z * rstd * gg[i].z, v[i].w * rstd * gg[i].w);
#pragma unroll
        for (int i = 0; i < 4; ++i) v[i] = nv[i];
    }
}

#ifndef COOP
#define COOP 1
#endif
constexpr int NPHASE = 8;

template <int MASK> __global__ void __launch_bounds__(NTHR) fwd_kernel(Params p_unused) {
    extern __shared__ __attribute__((aligned(16))) unsigned char lds[];
    PG8_LAS unsigned char* l3 = (PG8_LAS unsigned char*)lds;
    const int G = gridDim.x, c = blockIdx.x;
    if (tidx() < 30) ((unsigned long long*)(lds + PARAMS_OFF))[tidx()] = ((const unsigned long long*)__builtin_amdgcn_kernarg_segment_ptr())[tidx()];
    if (tidx() < 8) ((volatile LAS unsigned*)(lds + PARAMS_OFF + 256))[tidx()] = 0u;
    __syncthreads();
#define WS_PTR_() ((unsigned char*)(__attribute__((address_space(1))) unsigned char*)ld_u64_uniform(lds, 29))
    (void)xcd_barrier_post((unsigned*)(WS_PTR_() + WS_XBAR), (volatile LAS unsigned*)(lds + PARAMS_OFF + 256), (unsigned)G);
    if (c >= 160) (void)xcd_barrier_post((unsigned*)(WS_PTR_() + WS_XBAR2), (volatile LAS unsigned*)(lds + PARAMS_OFF + 272), (unsigned)(G - 160));
    if (((const int*)__builtin_amdgcn_kernarg_segment_ptr())[60] == 0x5a17) cg::this_grid().sync();
#define GRID_BARRIER() xcd_barrier_call((unsigned*)(WS_PTR_() + WS_XBAR), xb_xcc_id(), (volatile LAS unsigned*)(lds + PARAMS_OFF + 256), (unsigned)gridDim.x)
#if COOP
#define SEAM(k) do { if ((MASK & (1 << (k))) && (MASK >> ((k) + 1))) GRID_BARRIER(); } while (0)
#else
#define SEAM(k) do { } while (0)
#endif
    if (MASK & 1) { const Params p = load_params(lds); phase_prep(p, lds); } SEAM(0);
    if (MASK & 2) {
        const Params p = load_params(lds); unsigned char* ws = p.ws;
        pg8::Gemm g{(const bf16_t*)(ws + WS_H), (const bf16_t*)(ws + WS_BTIN), MPAD, NIN, D}; pg8::StaticOrder S; S.init(MPAD, NIN, G, c);
        EpiIn E{(bf16_t*)(ws + WS_PR), (bf16_t*)(ws + WS_QS), (float*)(ws + WS_F), (bf16_t*)(ws + WS_HI), (bf16_t*)(ws + WS_OG), (bf16_t*)p.out, (const float*)(ws + WS_MISC), p.out + O_SHP, p.out + O_SHS};
        pg8::gemm_phase<EpiIn, pg8::StaticOrder>(l3, g, S, E);
    } SEAM(1);
    if (MASK & 4) {
        { const Params p = load_params(lds); phase_lora_inputs(p); }
        GRID_BARRIER();
        { const Params p = load_params(lds); unsigned char* ws = p.ws;
          pg8::Gemm g{(const bf16_t*)(ws + WS_LIN), (const bf16_t*)(ws + WS_BTLO), MPAD, 1536, 256}; pg8::StaticOrder S; S.init(MPAD, 1536, G, c);
          EpiLora E{(bf16_t*)(ws + WS_LD), (bf16_t*)(ws + WS_AA), (bf16_t*)(ws + WS_GG), p.in[8], p.in[10]};
          pg8::gemm_phase<EpiLora, pg8::StaticOrder>(l3, g, S, E); }
        GRID_BARRIER();
    }
    if (MASK & 4) { const Params p = load_params(lds); phase_mix_seq(p, lds); }
#pragma nounroll
    for (int pass = (c >= 160 ? 0 : 1); pass < 2; ++pass) {
        unsigned char* ws = (unsigned char*)(__attribute__((address_space(1))) unsigned char*)ld_u64_uniform(lds, 29);
        unsigned* ctr = (unsigned*)(ws + WS_SUBBAR);
        const unsigned nb = (unsigned)(G - 160);
#define SEAM2(k) do { if (pass == 0) xcd_barrier_call((unsigned*)(WS_PTR_() + WS_XBAR2), xb_xcc_id(), (volatile LAS unsigned*)(lds + PARAMS_OFF + 272), (unsigned)(gridDim.x - 160)); else GRID_BARRIER(); } while (0)
        SEAM2(1);
        if (pass == 1) { { const Params p = load_params(lds); rwkv_post_pass(p); } GRID_BARRIER(); }
        {
            const Params p = load_params(lds);
            Order2 S; S.init(pass, D, G, c);
            bf16_t* mg = pass == 0 ? (bf16_t*)(ws + WS_MGS) - (size_t)TP * D : (bf16_t*)(ws + WS_MG);
            { pg8::Gemm g{(const bf16_t*)(ws + WS_OA), (const bf16_t*)(ws + WS_BTUPA), MPAD, D, 512}; OrderMerge SM; SM.o = S; EpiMerge2 E{mg, (const bf16_t*)p.out}; pg8::gemm_phase<EpiMerge2, OrderMerge>(l3, g, SM, E); }
        }
        SEAM2(2);
        {
            const Params p = load_params(lds);
            bf16_t* x1b = pass == 0 ? (bf16_t*)(ws + WS_X1BS) - (size_t)TP * D : (bf16_t*)(ws + WS_X1B);
            const bf16_t* mg = pass == 0 ? (const bf16_t*)(ws + WS_MGS) - (size_t)TP * D : (const bf16_t*)(ws + WS_MG);
            pg8::Gemm g{mg, (const bf16_t*)(ws + WS_BTOUT), MPAD, D, D}; Order2 S; S.init(pass, D, G, c);
            EpiOut E{p.in[0], p.in[1], p.out, x1b, (float*)(ws + WS_MISC + 4096)};
            pg8::gemm_phase<EpiOut, Order2>(l3, g, S, E);
        }
        SEAM2(3);
        {
            bf16_t* x1b = pass == 0 ? (bf16_t*)(ws + WS_X1BS) - (size_t)TP * D : (bf16_t*)(ws + WS_X1B);
            bf16_t* act = pass == 0 ? (bf16_t*)(ws + WS_ACTS) - (size_t)TP * DFF : (bf16_t*)(ws + WS_ACT);
            pg8::Gemm g{x1b, (const bf16_t*)(ws + WS_BTGU), MPAD, 2 * DFF, D}; Order2 S; S.init(pass, 2 * DFF, G, c);
            EpiGU E{act, (const float*)(ws + WS_MISC + 4096)};
            pg8::gemm_phase<EpiGU, Order2>(l3, g, S, E);
        }
        SEAM2(4);
        {
            const Params p = load_params(lds);
            bf16_t* act = pass == 0 ? (bf16_t*)(ws + WS_ACTS) - (size_t)TP * DFF : (bf16_t*)(ws + WS_ACT);
            pg8::Gemm g{act, (const bf16_t*)(ws + WS_BTDN), MPAD, D, DFF}; Order2 S; S.init(pass, D, G, c);
            EpiDown E{p.out};
            pg8::gemm_phase<EpiDown, Order2>(l3, g, S, E);
        }
#undef SEAM2
    }
    GRID_BARRIER();
    if (MASK & 128) { const Params p = load_params(lds); phase_final_norm(p); }
#undef SEAM
}

#if COOP
constexpr int NKERN = 1;
static const void* kern_ptr(int) { return (const void*)fwd_kernel<255>; }
#else
constexpr int NKERN = 8;
static const void* kern_ptr(int k) {
    switch (k) { case 0: return (const void*)fwd_kernel<1>; case 1: return (const void*)fwd_kernel<2>; case 2: return (const void*)fwd_kernel<4>; case 3: return (const void*)fwd_kernel<8>;
                 case 4: return (const void*)fwd_kernel<16>; case 5: return (const void*)fwd_kernel<32>; case 6: return (const void*)fwd_kernel<64>; default: return (const void*)fwd_kernel<128>; }
}
#endif
extern "C" void kernel_launch(void* const* d_in, const int* in_sizes, int n_in, void* d_out, int out_size, void* d_ws, size_t ws_size, hipStream_t stream) {
    static int grid = 0;
    if (grid == 0) {
        if (n_in != 28 || ws_size < WS_END4) { fprintf(stderr, "kernel_launch: unexpected n_in %d / ws_size %zu (need %zu)\n", n_in, ws_size, (size_t)WS_END4); grid = -1; return; }
        for (int k = 0; k < NKERN; ++k) if (hipFuncSetAttribute(kern_ptr(k), hipFuncAttributeMaxDynamicSharedMemorySize, LDS_BYTES) != hipSuccess) { fprintf(stderr, "kernel_launch: hipFuncSetAttribute failed\n"); grid = -1; return; }
        int dev = 0, cus = 0, per_cu = 0;
        (void)hipGetDevice(&dev); (void)hipDeviceGetAttribute(&cus, hipDeviceAttributeMultiprocessorCount, dev);
        (void)hipOccupancyMaxActiveBlocksPerMultiprocessor(&per_cu, kern_ptr(0), NTHR, LDS_BYTES);
        if (per_cu < 1) { fprintf(stderr, "kernel_launch: occupancy query says %d blocks per CU\n", per_cu); per_cu = 1; }
        grid = cus;
        (void)hipGetLastError();
    }
    if (grid < 0) return;
    (void)hipMemsetAsync((unsigned char*)d_ws + WS_XBAR, 0, (size_t)(WS_XBAR2 - WS_XBAR) + (size_t)XCD_BAR_WORDS * 4, stream);
    Params p{};
    for (int i = 0; i < 28; ++i) p.in[i] = (const float*)d_in[i];
    p.out = (float*)d_out; p.ws = (unsigned char*)d_ws;
#if COOP
    void* args[] = {&p};
    hipError_t e = hipLaunchCooperativeKernel(kern_ptr(0), dim3(grid), dim3(NTHR), args, LDS_BYTES, stream);
    if (e != hipSuccess) fprintf(stderr, "cooperative launch failed: %s (grid %d)\n", hipGetErrorString(e), grid);
#else
    for (int ph = 0; ph < NPHASE; ++ph) { void* args[] = {&p}; (void)hipLaunchKernel(kern_ptr(ph), dim3(grid), dim3(NTHR), args, LDS_BYTES, stream); }
#endif
}
```
